# Optimizing an MI355X kernel written in HIP

```python
import jax, jax.numpy as jnp
from jax import lax
import numpy as np

D_MODEL = 1024
BATCH = 2
SEQ = 8192
DEPTH = 2

HEAD_DIM = 64
MOBA_HEADS = 8
MOBA_BLOCK = 256
MOBA_TOPK = 3
MOBA_QCHUNK = 128
MOBA_W = MOBA_HEADS * HEAD_DIM
DIL_GROUPS = ((128, 1), (512, 4), (2048, 16))
DIL_HEADS_PER_GROUP = 4
DIL_HEADS = DIL_HEADS_PER_GROUP * len(DIL_GROUPS)
DIL_W = DIL_HEADS * HEAD_DIM
DIL_OUT_W = DIL_HEADS_PER_GROUP * HEAD_DIM
CONV_WIDTH = 512
CONV_K = 3
N_BRANCH = 3
SPLIT_SIZES = (MOBA_W, MOBA_W, MOBA_W, DIL_W, DIL_W, DIL_W,
               CONV_WIDTH, CONV_WIDTH, CONV_WIDTH, N_BRANCH * D_MODEL)
IN_COLS = sum(SPLIT_SIZES)
D_FF = 2816
FFN_CONV_K = 3
DN_ALPHA = (2 * DEPTH) ** 0.25
DN_BETA = (8 * DEPTH) ** -0.25
LN_EPS = 1e-5

kernel_name = "hybrid_moba_dilated_shortconv_deepnorm"


def layer_norm(x, g, b):
    xf = x.astype(jnp.float32)
    mu = jnp.mean(xf, axis=-1, keepdims=True)
    var = jnp.mean(jnp.square(xf - mu), axis=-1, keepdims=True)
    return ((xf - mu) * lax.rsqrt(var + LN_EPS)).astype(x.dtype) * g + b


def causal_dwconv(u, w):
    k = w.shape[0]
    s = u.shape[1]
    up = jnp.pad(u, ((0, 0), (k - 1, 0), (0, 0)))
    y = up[:, k - 1:k - 1 + s] * w[0]
    for j in range(1, k):
        y = y + up[:, k - 1 - j:k - 1 - j + s] * w[j]
    return y


def moba_attention(q, k, v):
    b, s, h, dh = q.shape
    nb = -(-s // MOBA_BLOCK)
    sp = nb * MOBA_BLOCK
    pad = ((0, 0), (0, sp - s), (0, 0), (0, 0))
    q, k, v = (jnp.pad(t, pad).transpose(0, 2, 1, 3) for t in (q, k, v))
    kb = k.reshape(b, h, nb, MOBA_BLOCK, dh)
    vb = v.reshape(b, h, nb, MOBA_BLOCK, dh)
    scale = HEAD_DIM ** -0.5
    kmean = jnp.mean(kb, axis=3)
    gate = jnp.einsum('bhsd,bhnd->bhsn', q, kmean).astype(jnp.float32)
    q_blk = jnp.arange(sp) // MOBA_BLOCK
    past = jnp.arange(nb)[None, :] < q_blk[:, None]
    gate = jnp.where(past, gate, -jnp.inf)
    n_sel = max(1, min(MOBA_TOPK, nb - 1))
    _, sel = lax.top_k(gate, n_sel)
    sel_valid = sel < q_blk[:, None]

    nc = sp // MOBA_QCHUNK
    qc_len = MOBA_QCHUNK

    def to_chunks(t):
        t = t.reshape(b, h, nc, qc_len, *t.shape[3:])
        return jnp.moveaxis(t, 2, 0)

    bi = jnp.arange(b)[:, None, None, None]
    hi = jnp.arange(h)[None, :, None, None]
    n_g = n_sel * MOBA_BLOCK

    def chunk_attn(args):
        qc, selc, validc, c = args
        q_pos = c * qc_len + jnp.arange(qc_len)
        blk = (c * qc_len) // MOBA_BLOCK
        kg = kb[bi, hi, selc]
        vg = vb[bi, hi, selc]
        ko = lax.dynamic_index_in_dim(kb, blk, axis=2, keepdims=False)
        vo = lax.dynamic_index_in_dim(vb, blk, axis=2, keepdims=False)
        s_sel = jnp.einsum('bhqd,bhqknd->bhqkn', qc, kg).astype(jnp.float32) * scale
        s_sel = jnp.where(validc[..., None], s_sel, -jnp.inf).reshape(b, h, qc_len, n_g)
        s_own = jnp.einsum('bhqd,bhnd->bhqn', qc, ko).astype(jnp.float32) * scale
        k_pos = blk * MOBA_BLOCK + jnp.arange(MOBA_BLOCK)
        s_own = jnp.where(k_pos[None, :] <= q_pos[:, None], s_own, -jnp.inf)
        p = jax.nn.softmax(jnp.concatenate([s_sel, s_own], axis=-1), axis=-1).astype(v.dtype)
        p_sel = p[..., :n_g].reshape(b, h, qc_len, n_sel, MOBA_BLOCK)
        return (jnp.einsum('bhqkn,bhqknd->bhqd', p_sel, vg)
                + jnp.einsum('bhqn,bhnd->bhqd', p[..., n_g:], vo))

    out = lax.map(chunk_attn, (to_chunks(q), to_chunks(sel), to_chunks(sel_valid),
                               jnp.arange(nc)))
    out = jnp.moveaxis(out, 0, 2).reshape(b, h, sp, dh)[:, :, :s]
    return out.transpose(0, 2, 1, 3).reshape(b, s, h * dh)


def dilated_group_attention(q, k, v, window, dilation):
    b, s, h, dh = q.shape
    span = window // dilation
    blk = span
    l = s // dilation
    nb = -(-l // blk)
    lp = nb * blk
    scale = HEAD_DIM ** -0.5

    def split(t):
        t = t.reshape(b, l, dilation, h, dh).transpose(0, 2, 3, 1, 4)
        return jnp.pad(t, ((0, 0), (0, 0), (0, 0), (0, lp - l), (0, 0)))

    def band(t):
        tb = t.reshape(b, dilation, h, nb, blk, dh)
        prev = jnp.pad(tb, ((0, 0), (0, 0), (0, 0), (1, 0), (0, 0), (0, 0)))[:, :, :, :-1]
        return jnp.concatenate([prev, tb], axis=4)

    qs, ks, vs = split(q), split(k), split(v)
    qb = qs.reshape(b, dilation, h, nb, blk, dh)
    kb, vb = band(ks), band(vs)
    sc = jnp.einsum('brhnqd,brhnkd->brhnqk', qb, kb).astype(jnp.float32) * scale
    q_pos = jnp.arange(nb)[:, None, None] * blk + jnp.arange(blk)[None, :, None]
    k_pos = jnp.arange(nb)[:, None, None] * blk - blk + jnp.arange(2 * blk)[None, None, :]
    dist = q_pos - k_pos
    mask = (dist >= 0) & (dist <= span) & (k_pos >= 0)
    sc = jnp.where(mask, sc, -jnp.inf)
    lse = jax.nn.logsumexp(sc, axis=-1)
    p = jnp.exp(sc - lse[..., None]).astype(v.dtype)
    o = jnp.einsum('brhnqk,brhnkd->brhnqd', p, vb)

    def merge(t):
        t = t.reshape(b, dilation, h, lp, *t.shape[5:])[:, :, :, :l]
        t = jnp.moveaxis(t, 3, 1)
        return t.reshape(b, s, h, *t.shape[4:])

    return merge(o), merge(lse)


def dilated_mixture(q, k, v):
    b, s = q.shape[:2]
    outs, lses = [], []
    for g, (window, dilation) in enumerate(DIL_GROUPS):
        hs = slice(g * DIL_HEADS_PER_GROUP, (g + 1) * DIL_HEADS_PER_GROUP)
        o, lse = dilated_group_attention(q[:, :, hs], k[:, :, hs], v[:, :, hs], window, dilation)
        outs.append(o)
        lses.append(lse)
    wts = jax.nn.softmax(jnp.stack(lses, axis=0), axis=0).astype(q.dtype)
    out = jnp.einsum('gbsh,gbshd->bshd', wts, jnp.stack(outs, axis=0))
    return out.reshape(b, s, DIL_OUT_W)


def mixer_sublayer(x, w_in, w_short_conv, w_moba_proj, w_dil_proj, w_conv_proj, w_mix_out):
    b, s, _ = x.shape
    split_points = tuple(int(i) for i in np.cumsum(SPLIT_SIZES)[:-1])
    qa, ka, va, qd, kd, vd, b_gate, c_gate, hc, gate_logits = jnp.split(
        x @ w_in, split_points, axis=-1)
    heads = lambda t, n: t.reshape(b, s, n, HEAD_DIM)
    y_moba = moba_attention(heads(qa, MOBA_HEADS), heads(ka, MOBA_HEADS), heads(va, MOBA_HEADS))
    y_conv = b_gate * causal_dwconv(c_gate * hc, w_short_conv)
    y_dil = dilated_mixture(heads(qd, DIL_HEADS), heads(kd, DIL_HEADS), heads(vd, DIL_HEADS))
    gates = jax.nn.sigmoid(gate_logits).reshape(b, s, N_BRANCH, D_MODEL)
    merged = (gates[:, :, 0] * (y_moba @ w_moba_proj)
              + gates[:, :, 1] * (y_conv @ w_conv_proj)
              + gates[:, :, 2] * (y_dil @ w_dil_proj))
    return merged @ w_mix_out


def conv_ffn_sublayer(x, w_up, w_ffn_conv, b_ffn_conv, w_down):
    u = causal_dwconv(x @ w_up, w_ffn_conv) + b_ffn_conv
    gate, val = jnp.split(u, 2, axis=-1)
    return (jax.nn.silu(gate) * val) @ w_down


def setup_inputs(seed: int = 0) -> dict:
    key = jax.random.key(seed)
    ks = jax.random.split(key, 16)
    nrm = lambda k, shape, sc: jax.random.normal(k, shape, jnp.float32) * sc
    L = DEPTH
    return {
        "x": nrm(ks[0], (BATCH, SEQ, D_MODEL), 1.0),
        "w_in": nrm(ks[1], (L, D_MODEL, IN_COLS), D_MODEL ** -0.5),
        "w_short_conv": nrm(ks[2], (L, CONV_K, CONV_WIDTH), CONV_K ** -0.5),
        "w_moba_proj": nrm(ks[3], (L, MOBA_W, D_MODEL), MOBA_W ** -0.5),
        "w_dil_proj": nrm(ks[4], (L, DIL_OUT_W, D_MODEL), DIL_OUT_W ** -0.5),
        "w_conv_proj": nrm(ks[5], (L, CONV_WIDTH, D_MODEL), CONV_WIDTH ** -0.5),
        "w_mix_out": nrm(ks[6], (L, D_MODEL, D_MODEL), DN_BETA * D_MODEL ** -0.5),
        "ln1_g": 1.0 + nrm(ks[7], (L, D_MODEL), 0.02),
        "ln1_b": nrm(ks[8], (L, D_MODEL), 0.02),
        "w_up": nrm(ks[9], (L, D_MODEL, 2 * D_FF), D_MODEL ** -0.5),
        "w_ffn_conv": nrm(ks[10], (L, FFN_CONV_K, 2 * D_FF), FFN_CONV_K ** -0.5),
        "b_ffn_conv": nrm(ks[11], (L, 2 * D_FF), 0.02),
        "w_down": nrm(ks[12], (L, D_FF, D_MODEL), DN_BETA * D_FF ** -0.5),
        "ln2_g": 1.0 + nrm(ks[13], (L, D_MODEL), 0.02),
        "ln2_b": nrm(ks[14], (L, D_MODEL), 0.02),
    }


def reference(x, w_in, w_short_conv, w_moba_proj, w_dil_proj, w_conv_proj, w_mix_out,
              ln1_g, ln1_b, w_up, w_ffn_conv, b_ffn_conv, w_down, ln2_g, ln2_b):
    for l in range(DEPTH):
        mix = mixer_sublayer(x, w_in[l], w_short_conv[l], w_moba_proj[l], w_dil_proj[l],
                             w_conv_proj[l], w_mix_out[l])
        x = layer_norm(DN_ALPHA * x + mix, ln1_g[l], ln1_b[l])
        ffn = conv_ffn_sublayer(x, w_up[l], w_ffn_conv[l], b_ffn_conv[l], w_down[l])
        x = layer_norm(DN_ALPHA * x + ffn, ln2_g[l], ln2_b[l])
    return x
```

```cpp
#include <hip/hip_runtime.h>
#include <hip/hip_cooperative_groups.h>
#include <cstdio>
#include <cstdint>
namespace cg = cooperative_groups;

#define LAS __attribute__((address_space(3)))
#define GAS __attribute__((address_space(1)))
typedef unsigned short bf16_t;
typedef short bf16x8 __attribute__((ext_vector_type(8)));
typedef short s16x4 __attribute__((ext_vector_type(4)));
typedef float f32x4 __attribute__((ext_vector_type(4)));
typedef float f32x16 __attribute__((ext_vector_type(16)));
typedef unsigned u32x4 __attribute__((ext_vector_type(4)));
typedef unsigned u32x2 __attribute__((ext_vector_type(2)));
typedef float f32x2_t __attribute__((ext_vector_type(2)));
typedef __bf16 bf16x2_t __attribute__((ext_vector_type(2)));

constexpr int M_TOK = 16384, SEQ = 8192, DM = 1024, INC = 8448, DFF = 2816, DFF2 = 5632;
constexpr float LN_EPS = 1e-5f;
constexpr float DN_ALPHA = 1.41421356237f;
constexpr int NPH_LAYER = 14, NPH = 2 * NPH_LAYER;

constexpr size_t MiB = 1u << 20;
constexpr size_t W_IN = 1 * MiB;
constexpr size_t W_MOBA = W_IN + (size_t)INC * DM * 2;
constexpr size_t W_CONV = W_MOBA + 1024 * 512 * 2;
constexpr size_t W_DIL = W_CONV + 1024 * 512 * 2;
constexpr size_t W_MIX = W_DIL + 1024 * 256 * 2;
constexpr size_t W_UP = W_MIX + 1024 * 1024 * 2;
constexpr size_t W_DOWN = W_UP + (size_t)DFF2 * DM * 2;
constexpr size_t W_END = W_DOWN + (size_t)DM * DFF * 2;
constexpr size_t WS_XB = W_END;
constexpr size_t WS_KMEAN = WS_XB + 32 * MiB;
constexpr size_t WS_LSE = WS_KMEAN + 131072;
constexpr size_t WS_BIG = WS_KMEAN + 1 * MiB;
constexpr size_t B_QA = WS_BIG, B_BC = B_QA + 16 * MiB, B_QD = B_BC + 16 * MiB, B_YD = B_QD + 24 * MiB, B_KA = B_YD + 8 * MiB,
                 B_VTA = B_KA + 16 * MiB, B_KD = B_VTA + 16 * MiB, B_VTD = B_KD + 24 * MiB, B_CC = B_VTD + 24 * MiB, B_HH = B_CC + 16 * MiB,
                 B_END = B_HH + 16 * MiB;
constexpr size_t B_G = B_KA;
constexpr size_t B_U = WS_BIG;
constexpr size_t B_H = WS_BIG + 88 * MiB;
constexpr size_t WS_NEED = B_END;
static_assert(W_END % 256 == 0 && B_G + 96 * MiB <= B_HH && B_H + 88 * MiB <= B_END, "ws map");

__device__ __forceinline__ unsigned cvtpk(float lo, float hi) { f32x2_t v = {lo, hi}; bf16x2_t b = __builtin_convertvector(v, bf16x2_t); return __builtin_bit_cast(unsigned, b); }
__device__ __forceinline__ float bflo(unsigned w) { return __uint_as_float(w << 16); }
__device__ __forceinline__ float bfhi(unsigned w) { return __uint_as_float(w & 0xffff0000u); }
__device__ __forceinline__ float fast_sigmoid(float x) { return __builtin_amdgcn_rcpf(1.0f + __builtin_amdgcn_exp2f(-1.44269504089f * x)); }

namespace pg8 {
constexpr int BM = 256, BK = 64, HALF = 128, HTB = HALF * BK * 2, STAGE_BYTES = 8 * HTB, NXCD = 8, WGM = 8;
__host__ __device__ __forceinline__ int lds_byte(int r, int c) { const int st = (r >> 4) * 2 + (c >> 5), rr = r & 15, cc = c & 31, ob = rr * 64 + cc * 2; return st * 1024 + (ob ^ (((ob >> 9) & 1) << 5)); }
__host__ __device__ __forceinline__ void stage_rc(int b, int& R, int& C) { const int st = b / 1024, sb = b % 1024, swz = sb ^ (((sb >> 9) & 1) << 5); R = (st >> 1) * 16 + swz / 64; C = (st & 1) * 32 + (swz % 64) / 2; }
__host__ __device__ __forceinline__ int perm32(int rho) { const int n = rho >> 4, i = rho & 15; return 8 * (i >> 2) + 4 * n + (i & 3); }

struct GUnit { const char* A; const char* B; unsigned ldb; bf16_t* O; int ldc; int r0, c0; };

__device__ __forceinline__ void tile_order(int wgid, int nM, int nN, int& pm, int& pn) {
    const int nwg = nM * nN;
    { const int q = nwg / NXCD, r = nwg % NXCD, xcd = wgid % NXCD, off = wgid / NXCD; wgid = (xcd < r ? xcd * (q + 1) : r * (q + 1) + (xcd - r) * q) + off; }
    const int nig = WGM * nN, gid = wgid / nig, fm = gid * WGM, gsz = (nM - fm) < WGM ? (nM - fm) : WGM;
    pm = fm + ((wgid % nig) % gsz); pn = (wgid % nig) / gsz;
}

template <class Sched, class Epi>
__device__ __forceinline__ void gemm_phase(LAS unsigned char* lds, const int tid, const int K, const unsigned lda, const Sched& S, const Epi& E) {
    const int wid = __builtin_amdgcn_readfirstlane(tid >> 6), lane = tid & 63, wr = wid >> 2, wc = wid & 3, fr = lane & 15, fq = lane >> 4;
    const int nt = K / BK;
    unsigned voffA[2], RB[2], CC2[2];
#pragma unroll
    for (int i = 0; i < 2; ++i) { int R, C; stage_rc(tid * 16 + i * 8192, R, C); const int Rb = (R & ~31) + perm32(R & 31);
        voffA[i] = (unsigned)R * lda + (unsigned)C * 2u; RB[i] = (unsigned)Rb; CC2[i] = (unsigned)C * 2u; }
    const size_t kstep = (size_t)(BK * 2);
    const size_t hstepA = (size_t)HALF * lda;
    const unsigned ldsw = (unsigned)wid * 1024u;
    const int aoff = lds_byte(wr * 64 + fr, fq * 8), boff = lds_byte(wc * 32 + fr, fq * 8);
#define PG8_SA(b, h) (((b) * 2 + (h)) * HTB)
#define PG8_SB(b, h) ((4 + (b) * 2 + (h)) * HTB)
#define PG8_STAGE(bufoff, gbase, voff) do { _Pragma("unroll") for (int _i = 0; _i < 2; ++_i) \
        __builtin_amdgcn_global_load_lds((const unsigned*)((const char*)(gbase) + (voff)[_i]), (LAS unsigned*)(lds + (bufoff) + ldsw + _i * 8192), 16, 0, 0); } while (0)
#define PG8_LDA(dst, b, h) do { _Pragma("unroll") for (int m = 0; m < 4; ++m) _Pragma("unroll") for (int k = 0; k < 2; ++k) dst[m][k] = *(const LAS bf16x8*)(lds + PG8_SA(b, h) + aoff + m * 2048 + k * 1024); } while (0)
#define PG8_LDB(dst, b, h) do { _Pragma("unroll") for (int n = 0; n < 2; ++n) _Pragma("unroll") for (int k = 0; k < 2; ++k) dst[n][k] = *(const LAS bf16x8*)(lds + PG8_SB(b, h) + boff + n * 2048 + k * 1024); } while (0)
#define PG8_MMA(ai, bj, At, Bt) do { __builtin_amdgcn_s_setprio(1); _Pragma("unroll") for (int m = 0; m < 4; ++m) _Pragma("unroll") for (int n = 0; n < 2; ++n) _Pragma("unroll") for (int k = 0; k < 2; ++k) \
        acc[ai][bj][m][n] = __builtin_amdgcn_mfma_f32_16x16x32_bf16(Bt[n][k], At[m][k], acc[ai][bj][m][n], 0, 0, 0); __builtin_amdgcn_s_setprio(0); } while (0)
#define PG8_WAIT_V(n) asm volatile("s_waitcnt vmcnt(" #n ")" ::: "memory")
#define PG8_WAIT_L(n) asm volatile("s_waitcnt lgkmcnt(" #n ")" ::: "memory")
#define PG8_BAR __builtin_amdgcn_s_barrier()
#define PG8_SCHED __builtin_amdgcn_sched_barrier(0)
    GUnit cur, nxt; int ui = 0;
    if (!S.next(0, cur)) return;
    f32x4 acc[2][2][4][2];
#pragma unroll
    for (int a = 0; a < 2; ++a)
#pragma unroll
        for (int b = 0; b < 2; ++b)
#pragma unroll
            for (int m = 0; m < 4; ++m)
#pragma unroll
                for (int n = 0; n < 2; ++n) acc[a][b][m][n] = (f32x4){0.f, 0.f, 0.f, 0.f};
    bf16x8 At[4][2], B0[2][2], B1[2][2];
    const char* cA = cur.A; const char* cB = cur.B;
    unsigned vBc[2] = {RB[0] * cur.ldb + CC2[0], RB[1] * cur.ldb + CC2[1]};
    size_t hBc = (size_t)HALF * cur.ldb;
    PG8_STAGE(PG8_SB(0, 0), cB, vBc); PG8_STAGE(PG8_SB(0, 1), cB + hBc, vBc); PG8_STAGE(PG8_SA(0, 0), cA, voffA); PG8_STAGE(PG8_SA(0, 1), cA + hstepA, voffA);
    if (wr == 1) PG8_BAR;
    PG8_WAIT_V(2); PG8_BAR;
    PG8_STAGE(PG8_SB(1, 0), cB + kstep, vBc); PG8_STAGE(PG8_SA(1, 0), cA + kstep, voffA); PG8_STAGE(PG8_SB(1, 1), cB + hBc + kstep, vBc);
    PG8_WAIT_V(6); PG8_BAR;
    for (;;) {
        const bool has_next = S.next(ui + 1, nxt);
        const char* nA = has_next ? nxt.A : cA; const char* nB = has_next ? nxt.B : cB;
        const unsigned nldb = has_next ? nxt.ldb : cur.ldb;
        unsigned vBn[2] = {RB[0] * nldb + CC2[0], RB[1] * nldb + CC2[1]};
        const size_t hBn = (size_t)HALF * nldb;
        for (int t = 0; t < nt; t += 2) {
            const bool last = (t == nt - 2);
            const char* a1 = cA + (size_t)(t + 1) * kstep;
            const char* a2 = last ? nA : cA + (size_t)(t + 2) * kstep; const char* b2 = last ? nB : cB + (size_t)(t + 2) * kstep;
            const char* a3 = a2 + kstep; const char* b3 = b2 + kstep;
            unsigned vB[2] = {last ? vBn[0] : vBc[0], last ? vBn[1] : vBc[1]};
            const size_t hB = last ? hBn : hBc;
            PG8_LDB(B0, 0, 0); PG8_LDB(B1, 0, 1); PG8_SCHED; PG8_LDA(At, 0, 0); PG8_STAGE(PG8_SA(1, 1), a1 + hstepA, voffA);
            PG8_WAIT_V(8); PG8_WAIT_L(0); PG8_BAR; PG8_MMA(0, 0, At, B0); PG8_MMA(0, 1, At, B1); PG8_BAR; PG8_SCHED;
            PG8_LDA(At, 0, 1); PG8_STAGE(PG8_SB(0, 0), b2, vB); PG8_STAGE(PG8_SB(0, 1), b2 + hB, vB); PG8_STAGE(PG8_SA(0, 0), a2, voffA);
            PG8_WAIT_V(8); PG8_WAIT_L(0); PG8_BAR; PG8_MMA(1, 0, At, B0); PG8_MMA(1, 1, At, B1); PG8_BAR; PG8_SCHED;
            PG8_LDB(B0, 1, 0); PG8_LDB(B1, 1, 1); PG8_SCHED; PG8_LDA(At, 1, 0); PG8_STAGE(PG8_SA(0, 1), a2 + hstepA, voffA);
            PG8_WAIT_V(8); PG8_WAIT_L(0); PG8_BAR; PG8_MMA(0, 0, At, B0); PG8_MMA(0, 1, At, B1); PG8_BAR; PG8_SCHED;
            PG8_LDA(At, 1, 1); PG8_STAGE(PG8_SB(1, 0), b3, vB); PG8_STAGE(PG8_SB(1, 1), b3 + hB, vB); PG8_STAGE(PG8_SA(1, 0), a3, voffA);
            PG8_WAIT_V(8); PG8_WAIT_L(0); PG8_BAR; PG8_MMA(1, 0, At, B0); PG8_MMA(1, 1, At, B1); PG8_BAR; PG8_SCHED;
        }
        if (wr == 0) PG8_BAR;
        E(acc, cur, wr, wc, fr, fq);
        if (!has_next) break;
#pragma unroll
        for (int a = 0; a < 2; ++a)
#pragma unroll
            for (int b = 0; b < 2; ++b)
#pragma unroll
                for (int m = 0; m < 4; ++m)
#pragma unroll
                    for (int n = 0; n < 2; ++n) acc[a][b][m][n] = (f32x4){0.f, 0.f, 0.f, 0.f};
        cur = nxt; cA = nA; cB = nB; vBc[0] = vBn[0]; vBc[1] = vBn[1]; hBc = hBn; ++ui;
        if (wr == 1) PG8_BAR;
    }
    PG8_WAIT_V(0);
    PG8_BAR;
#undef PG8_SA
#undef PG8_SB
#undef PG8_STAGE
#undef PG8_LDA
#undef PG8_LDB
#undef PG8_MMA
#undef PG8_WAIT_V
#undef PG8_WAIT_L
#undef PG8_BAR
#undef PG8_SCHED
}

template <int ACT> struct EpiBf16 {
    __device__ __forceinline__ void operator()(const f32x4 (&acc)[2][2][4][2], const GUnit& u, int wr, int wc, int fr, int fq) const {
#pragma unroll
        for (int ai = 0; ai < 2; ++ai)
#pragma unroll
            for (int m = 0; m < 4; ++m) {
                const int row = u.r0 + ai * HALF + wr * 64 + m * 16 + fr;
                bf16_t* rowp = u.O + (size_t)row * u.ldc + u.c0 + wc * 32 + 8 * fq;
#pragma unroll
                for (int bj = 0; bj < 2; ++bj) {
                    f32x4 v0 = acc[ai][bj][m][0], v1 = acc[ai][bj][m][1];
                    if (ACT == 1) {
#pragma unroll
                        for (int k = 0; k < 4; ++k) { v0[k] = fast_sigmoid(v0[k]); v1[k] = fast_sigmoid(v1[k]); }
                    }
                    u32x4 w; w.x = cvtpk(v0[0], v0[1]); w.y = cvtpk(v0[2], v0[3]); w.z = cvtpk(v1[0], v1[1]); w.w = cvtpk(v1[2], v1[3]);
                    *(u32x4*)(rowp + bj * HALF) = w;
                }
            }
    }
};
template <bool FIRST> struct EpiMerge {
    const bf16_t* G; bf16_t* Mg; int gi;
    __device__ __forceinline__ void operator()(const f32x4 (&acc)[2][2][4][2], const GUnit& u, int wr, int wc, int fr, int fq) const {
#pragma unroll
        for (int ai = 0; ai < 2; ++ai)
#pragma unroll
            for (int m = 0; m < 4; ++m) {
                const int row = u.r0 + ai * HALF + wr * 64 + m * 16 + fr;
#pragma unroll
                for (int bj = 0; bj < 2; ++bj) {
                    const int col = u.c0 + bj * HALF + wc * 32 + 8 * fq;
                    const u32x4 g = *(const u32x4*)(G + (size_t)row * 3072 + gi * 1024 + col);
                    bf16_t* mp = Mg + (size_t)row * 1024 + col;
                    u32x4 o = (u32x4){0u, 0u, 0u, 0u};
                    if (!FIRST) o = *(const u32x4*)mp;
                    const f32x4 v0 = acc[ai][bj][m][0], v1 = acc[ai][bj][m][1];
                    u32x4 w;
                    w.x = cvtpk(bflo(g.x) * v0[0] + bflo(o.x), bfhi(g.x) * v0[1] + bfhi(o.x));
                    w.y = cvtpk(bflo(g.y) * v0[2] + bflo(o.y), bfhi(g.y) * v0[3] + bfhi(o.y));
                    w.z = cvtpk(bflo(g.z) * v1[0] + bflo(o.z), bfhi(g.z) * v1[1] + bfhi(o.z));
                    w.w = cvtpk(bflo(g.w) * v1[2] + bflo(o.w), bfhi(g.w) * v1[3] + bfhi(o.w));
                    *(u32x4*)mp = w;
                }
            }
    }
};
struct EpiRes {
    const float* base; float* out;
    __device__ __forceinline__ void operator()(const f32x4 (&acc)[2][2][4][2], const GUnit& u, int wr, int wc, int fr, int fq) const {
#pragma unroll
        for (int ai = 0; ai < 2; ++ai)
#pragma unroll
            for (int m = 0; m < 4; ++m) {
                const int row = u.r0 + ai * HALF + wr * 64 + m * 16 + fr;
#pragma unroll
                for (int bj = 0; bj < 2; ++bj) {
                    const size_t off = (size_t)row * 1024 + u.c0 + bj * HALF + wc * 32 + 8 * fq;
                    const f32x4 b0 = *(const f32x4*)(base + off), b1 = *(const f32x4*)(base + off + 4);
                    *(f32x4*)(out + off) = b0 * DN_ALPHA + acc[ai][bj][m][0];
                    *(f32x4*)(out + off + 4) = b1 * DN_ALPHA + acc[ai][bj][m][1];
                }
            }
    }
};

struct SchedSimple {
    int nM, nN, G, c; const char* A; size_t a_tile; const char* B; size_t b_tile; unsigned ldb; bf16_t* O; int ldc;
    __device__ __forceinline__ bool next(int i, GUnit& u) const {
        const long L = (long)i * G + c; if (L >= (long)nM * nN) return false;
        int pm, pn; tile_order((int)L, nM, nN, pm, pn);
        u.A = A + (size_t)pm * a_tile; u.B = B + (size_t)pn * b_tile; u.ldb = ldb; u.O = O; u.ldc = ldc; u.r0 = pm * 256; u.c0 = pn * 256; return true;
    }
};
struct SchedIN {
    int G, c; const char* xb; const char* wt; unsigned char* ws;
    __device__ __forceinline__ bool next(int i, GUnit& u) const {
        const long L = (long)i * G + c; if (L >= 1344) return false;
        if (L < 1024) {
            int pm, pn; tile_order((int)L, 64, 16, pm, pn);
            const int wtile = pn < 4 ? pn : (pn < 10 ? pn + 2 : pn + 5);
            u.A = xb + (size_t)pm * 256 * 2048; u.B = wt + (size_t)wtile * 256 * 2048; u.ldb = 2048; u.r0 = pm * 256;
            size_t sec; int ct, ldc = 512;
            if (wtile < 2) { sec = B_QA; ct = wtile; }
            else if (wtile < 4) { sec = B_KA; ct = wtile - 2; }
            else if (wtile < 9) { sec = B_QD; ct = wtile - 6; ldc = 768; }
            else if (wtile < 12) { sec = B_KD; ct = wtile - 9; ldc = 768; }
            else if (wtile < 17) { sec = B_BC; ct = wtile - 15; }
            else if (wtile < 19) { sec = B_CC; ct = wtile - 17; }
            else { sec = B_HH; ct = wtile - 19; }
            u.O = (bf16_t*)(ws + sec); u.ldc = ldc; u.c0 = ct * 256;
        } else {
            const int v = (int)L - 1024, sub = v >> 6, it = v & 63;
            u.ldc = 16384; u.c0 = it * 256;
            if (sub < 2) {
                u.A = wt + (size_t)(1024 + 256 * sub) * 2048; u.B = xb + (size_t)it * 256 * 2048; u.ldb = 2048; u.O = (bf16_t*)(ws + B_VTA); u.r0 = 256 * sub;
            } else {
                const int g = sub - 2, r = 1 << (2 * g), b = it >> 5, idx = it & 31, per = 32 >> (2 * g), rho = idx / per, p0 = (idx % per) * 256;
                u.A = wt + (size_t)(3072 + 256 * g) * 2048; u.B = xb + (size_t)(b * SEQ + p0 * r + rho) * 2048; u.ldb = 2048u * (unsigned)r;
                u.O = (bf16_t*)(ws + B_VTD); u.r0 = 256 * g;
            }
        }
        return true;
    }
};
}

__device__ __forceinline__ int crow(int r, int hi) { return (r & 3) + 8 * (r >> 2) + 4 * hi; }
struct AttnSt { f32x16 o0, o1; float m, l; };
struct Frags { bf16x8 k[4]; s16x4 v0[4]; s16x4 v1[4]; };

__device__ __forceinline__ void load_frags(Frags& f, const bf16_t* kp, const bf16_t* v0p, const bf16_t* v1p) {
#pragma unroll
    for (int d0 = 0; d0 < 4; ++d0) f.k[d0] = *(const bf16x8*)(kp + 16 * d0);
#pragma unroll
    for (int j = 0; j < 4; ++j) { f.v0[j] = *(const s16x4*)(v0p + 8 * j); f.v1[j] = *(const s16x4*)(v1p + 8 * j); }
}
#define CAT8(a, b) (bf16x8){a[0], a[1], a[2], a[3], b[0], b[1], b[2], b[3]}
__device__ __forceinline__ void attn_step(AttnSt& st, const bf16x8 (&qf)[4], const Frags& f, int kvbase, int hi, int lo_b, int hi_b) {
    f32x16 p;
#pragma unroll
    for (int r = 0; r < 16; ++r) p[r] = 0.f;
#pragma unroll
    for (int d0 = 0; d0 < 4; ++d0) p = __builtin_amdgcn_mfma_f32_32x32x16_bf16(f.k[d0], qf[d0], p, 0, 0, 0);
    const float C2 = 0.125f * 1.44269504089f;
    float mx = -INFINITY;
#pragma unroll
    for (int r = 0; r < 16; ++r) { const int kv = kvbase + crow(r, hi); float s = p[r] * C2; s = (kv >= lo_b && kv <= hi_b) ? s : -INFINITY; p[r] = s; mx = fmaxf(mx, s); }
    mx = fmaxf(mx, __shfl_xor(mx, 32));
    const float mn = fmaxf(st.m, mx);
    const float alpha = __builtin_amdgcn_exp2f(st.m - mn);
    float ps = 0.f;
#pragma unroll
    for (int r = 0; r < 16; ++r) { p[r] = __builtin_amdgcn_exp2f(p[r] - mn); ps += p[r]; }
    st.l = st.l * alpha + ps; st.m = mn;
#pragma unroll
    for (int r = 0; r < 16; ++r) { st.o0[r] *= alpha; st.o1[r] *= alpha; }
    u32x4 wa, wb;
    wa.x = cvtpk(p[0], p[1]); wa.y = cvtpk(p[2], p[3]); wa.z = cvtpk(p[4], p[5]); wa.w = cvtpk(p[6], p[7]);
    wb.x = cvtpk(p[8], p[9]); wb.y = cvtpk(p[10], p[11]); wb.z = cvtpk(p[12], p[13]); wb.w = cvtpk(p[14], p[15]);
    const bf16x8 pa = __builtin_bit_cast(bf16x8, wa), pb = __builtin_bit_cast(bf16x8, wb);
    st.o0 = __builtin_amdgcn_mfma_f32_32x32x16_bf16(CAT8(f.v0[0], f.v0[1]), pa, st.o0, 0, 0, 0);
    st.o0 = __builtin_amdgcn_mfma_f32_32x32x16_bf16(CAT8(f.v0[2], f.v0[3]), pb, st.o0, 0, 0, 0);
    st.o1 = __builtin_amdgcn_mfma_f32_32x32x16_bf16(CAT8(f.v1[0], f.v1[1]), pa, st.o1, 0, 0, 0);
    st.o1 = __builtin_amdgcn_mfma_f32_32x32x16_bf16(CAT8(f.v1[2], f.v1[3]), pb, st.o1, 0, 0, 0);
}
__device__ __forceinline__ void attn_init(AttnSt& st) {
#pragma unroll
    for (int r = 0; r < 16; ++r) { st.o0[r] = 0.f; st.o1[r] = 0.f; }
    st.m = -1e30f; st.l = 0.f;
}
__device__ __forceinline__ float attn_store(const AttnSt& st, bf16_t* orow, int hi) {
    const float lt = st.l + __shfl_xor(st.l, 32);
    const float inv = 1.0f / lt;
#pragma unroll
    for (int g4 = 0; g4 < 4; ++g4) {
        u32x2 a, b;
        a.x = cvtpk(st.o0[4 * g4] * inv, st.o0[4 * g4 + 1] * inv); a.y = cvtpk(st.o0[4 * g4 + 2] * inv, st.o0[4 * g4 + 3] * inv);
        b.x = cvtpk(st.o1[4 * g4] * inv, st.o1[4 * g4 + 1] * inv); b.y = cvtpk(st.o1[4 * g4 + 2] * inv, st.o1[4 * g4 + 3] * inv);
        *(u32x2*)(orow + 8 * g4 + 4 * hi) = a;
        *(u32x2*)(orow + 32 + 8 * g4 + 4 * hi) = b;
    }
    return lt;
}

__device__ __forceinline__ void moba_tile(unsigned char* ws, int b, int h, int qblk, int w, int lane) {
    const int l31 = lane & 31, hi = lane >> 5;
    const int q = qblk * 256 + w * 32 + l31;
    bf16_t* Qrow = (bf16_t*)(ws + B_QA) + (size_t)(b * SEQ + q) * 512 + h * 64;
    const bf16_t* Kl = (const bf16_t*)(ws + B_KA) + (size_t)(b * SEQ + l31) * 512 + h * 64 + 8 * hi;
    const bf16_t* V0 = (const bf16_t*)(ws + B_VTA) + (size_t)(h * 64 + l31) * 16384 + b * SEQ + 4 * hi;
    const bf16_t* V1 = V0 + (size_t)32 * 16384;
    unsigned mask = 0u;
    if (qblk > 0) {
        float qv[32];
#pragma unroll
        for (int c4 = 0; c4 < 4; ++c4) { const u32x4 t = *(const u32x4*)(Qrow + 32 * hi + 8 * c4);
            qv[8 * c4 + 0] = bflo(t.x); qv[8 * c4 + 1] = bfhi(t.x); qv[8 * c4 + 2] = bflo(t.y); qv[8 * c4 + 3] = bfhi(t.y);
            qv[8 * c4 + 4] = bflo(t.z); qv[8 * c4 + 5] = bfhi(t.z); qv[8 * c4 + 6] = bflo(t.w); qv[8 * c4 + 7] = bfhi(t.w); }
        const float* km = (const float*)(ws + WS_KMEAN) + (size_t)((b * 8 + h) * 32) * 64 + 32 * hi;
        float g[32];
#pragma unroll
        for (int j = 0; j < 32; ++j) {
            float s = 0.f;
            if (j < qblk) {
#pragma unroll
                for (int d4 = 0; d4 < 8; ++d4) { const f32x4 kk = *(const f32x4*)(km + j * 64 + 4 * d4);
                    s += qv[4 * d4] * kk[0] + qv[4 * d4 + 1] * kk[1] + qv[4 * d4 + 2] * kk[2] + qv[4 * d4 + 3] * kk[3]; }
            }
            g[j] = s + __shfl_xor(s, 32);
        }
#pragma unroll
        for (int pass = 0; pass < 3; ++pass) {
            float best = -INFINITY; int bi = -1;
#pragma unroll
            for (int j = 0; j < 32; ++j) { const bool ok = (j < qblk) && !((mask >> j) & 1u) && (g[j] > best); best = ok ? g[j] : best; bi = ok ? j : bi; }
            if (bi >= 0) mask |= 1u << bi;
        }
    }
    unsigned need = 0u;
    for (int j = 0; j < qblk; ++j) if (__any((int)((mask >> j) & 1u))) need |= 1u << j;
    need |= 1u << qblk;
    bf16x8 qf[4];
#pragma unroll
    for (int d0 = 0; d0 < 4; ++d0) qf[d0] = *(const bf16x8*)(Qrow + 16 * d0 + 8 * hi);
    AttnSt st; attn_init(st);
    int blk = __builtin_ctz(need); need &= need - 1u; int i = 0;
    Frags f, fn;
    { const int kv = blk * 256; load_frags(f, Kl + (size_t)kv * 512, V0 + kv, V1 + kv); }
    for (;;) {
        const int nst = (blk == qblk) ? (w + 1) : 8;
        int nblk = blk, ni = i + 1; bool has = true;
        if (ni >= nst) { if (need == 0u) has = false; else { nblk = __builtin_ctz(need); need &= need - 1u; ni = 0; } }
        if (has) { const int kv = nblk * 256 + ni * 32; load_frags(fn, Kl + (size_t)kv * 512, V0 + kv, V1 + kv); }
        const bool own = (blk == qblk);
        const bool sel = own || ((mask >> blk) & 1u);
        const int lo_b = sel ? -1 : 0x7fffffff, hi_b = own ? q : 0x7ffffff0;
        attn_step(st, qf, f, blk * 256 + i * 32, hi, lo_b, hi_b);
        if (!has) break;
        f = fn; blk = nblk; i = ni;
    }
    attn_store(st, Qrow, hi);
}

__device__ __forceinline__ void dil_tile(unsigned char* ws, int tile, int lane) {
    const int l31 = lane & 31, hi = lane >> 5;
    const int b = tile / 3072, rem = tile % 3072, hd = rem >> 8, t = rem & 255, g = hd >> 2, sh = 2 * g, r = 1 << sh;
    const int len = SEQ >> sh, tpr = len >> 5, rho = t / tpr, p0 = (t % tpr) * 32;
    const int p = p0 + l31, tok = p * r + rho;
    bf16_t* Qrow = (bf16_t*)(ws + B_QD) + (size_t)(b * SEQ + tok) * 768 + hd * 64;
    const bf16_t* Kl = (const bf16_t*)(ws + B_KD) + (size_t)(b * SEQ + rho) * 768 + hd * 64 + 8 * hi;
    const bf16_t* V0 = (const bf16_t*)(ws + B_VTD) + (size_t)(hd * 64 + l31) * 16384 + b * SEQ + rho * len + 4 * hi;
    const bf16_t* V1 = V0 + (size_t)32 * 16384;
    bf16x8 qf[4];
#pragma unroll
    for (int d0 = 0; d0 < 4; ++d0) qf[d0] = *(const bf16x8*)(Qrow + 16 * d0 + 8 * hi);
    AttnSt st; attn_init(st);
    int s = (p0 >= 128) ? 0 : ((128 - p0) >> 5);
    Frags f, fn;
    { const int kv = p0 - 128 + 32 * s; load_frags(f, Kl + (size_t)((kv + l31) * r) * 768, V0 + kv, V1 + kv); }
    for (;;) {
        const bool has = (s + 1) < 5;
        if (has) { const int kv = p0 - 128 + 32 * (s + 1); load_frags(fn, Kl + (size_t)((kv + l31) * r) * 768, V0 + kv, V1 + kv); }
        attn_step(st, qf, f, p0 - 128 + 32 * s, hi, p - 128, p);
        if (!has) break;
        f = fn; ++s;
    }
    const float lt = attn_store(st, Qrow, hi);
    if (hi == 0) ((float*)(ws + WS_LSE))[(size_t)(b * SEQ + tok) * 12 + hd] = 0.69314718056f * (st.m + __builtin_amdgcn_logf(lt));
}

__device__ __forceinline__ float wave_sum(float v) {
#pragma unroll
    for (int o = 1; o < 64; o <<= 1) v += __shfl_xor(v, o);
    return v;
}
__device__ __forceinline__ void transpose_item(const float* W, int K, int N, bf16_t* WT, LAS float* scr, int item, int lane) {
    const int nblk = N / 32, kb = item / nblk, nb = item % nblk, k0 = 64 * kb, n0 = 32 * nb;
#pragma unroll 8
    for (int i = 0; i < 32; ++i) { const int kk = 2 * i + (lane >> 5); scr[kk * 33 + (lane & 31)] = W[(size_t)(k0 + kk) * N + n0 + (lane & 31)]; }
    asm volatile("s_waitcnt lgkmcnt(0)" ::: "memory");
    const int c = lane & 7;
#pragma unroll
    for (int j = 0; j < 4; ++j) { const int n = (lane >> 3) + 8 * j; const LAS float* s = scr + (8 * c) * 33 + n;
        u32x4 o; o.x = cvtpk(s[0 * 33], s[1 * 33]); o.y = cvtpk(s[2 * 33], s[3 * 33]); o.z = cvtpk(s[4 * 33], s[5 * 33]); o.w = cvtpk(s[6 * 33], s[7 * 33]);
        *(u32x4*)(WT + (size_t)(n0 + n) * K + k0 + 8 * c) = o; }
    asm volatile("s_waitcnt lgkmcnt(0)" ::: "memory");
}

struct Params { const float* in[15]; float* out; unsigned char* ws; int ph_lo, ph_hi; };

__global__ void __launch_bounds__(512, 2) mega_fwd(Params P) {
    extern __shared__ __attribute__((aligned(16))) unsigned char lds_raw[];
    LAS unsigned char* lds = (LAS unsigned char*)lds_raw;
    cg::grid_group grid = cg::this_grid();
    for (int ph = P.ph_lo; ph < P.ph_hi; ++ph) {
        int tid = threadIdx.x; asm volatile("" : "+v"(tid));
        size_t zoff = 0; asm volatile("" : "+s"(zoff));
        unsigned char* ws = (unsigned char*)((GAS unsigned char*)P.ws + zoff);
        float* outp = (float*)((GAS float*)P.out + zoff);
#define INP(i) ((const float*)((const GAS float*)P.in[i] + zoff))
        int G = gridDim.x, wg = blockIdx.x; asm volatile("" : "+s"(G), "+s"(wg));
        const int lane = tid & 63, wave = __builtin_amdgcn_readfirstlane(tid >> 6);
        const int gw = wg * 8 + wave, NGW = G * 8;
        const int gt = wg * 512 + tid, NGT = G * 512;
        bf16_t* XB = (bf16_t*)(ws + WS_XB);
        const int l = ph / NPH_LAYER, k = ph % NPH_LAYER;
        const float* xres = (l == 0) ? INP(0) : outp;
#ifdef ONLY
        if (k != ONLY) continue;
#endif
#ifdef SKIPK
        if (k == SKIPK) continue;
#endif
#ifdef SKIPK2
        if (k == SKIPK2) continue;
#endif
        switch (k) {
        case 0: {
            LAS float* scr = (LAS float*)(lds + wave * 16384);
            const int I0 = 16 * 264, I1 = 8 * 32, I2 = 8 * 32, I3 = 4 * 32, I4 = 16 * 32, I5 = 16 * 176, I6 = 44 * 32;
            const int NIT = I0 + I1 + I2 + I3 + I4 + I5 + I6;
            for (int it = gw; it < NIT; it += NGW) {
                int r = it;
                if (r < I0) { transpose_item(INP(1) + (size_t)l * DM * INC, DM, INC, (bf16_t*)(ws + W_IN), scr, r, lane); continue; } r -= I0;
                if (r < I1) { transpose_item(INP(3) + (size_t)l * 512 * DM, 512, DM, (bf16_t*)(ws + W_MOBA), scr, r, lane); continue; } r -= I1;
                if (r < I2) { transpose_item(INP(5) + (size_t)l * 512 * DM, 512, DM, (bf16_t*)(ws + W_CONV), scr, r, lane); continue; } r -= I2;
                if (r < I3) { transpose_item(INP(4) + (size_t)l * 256 * DM, 256, DM, (bf16_t*)(ws + W_DIL), scr, r, lane); continue; } r -= I3;
                if (r < I4) { transpose_item(INP(6) + (size_t)l * DM * DM, DM, DM, (bf16_t*)(ws + W_MIX), scr, r, lane); continue; } r -= I4;
                if (r < I5) { transpose_item(INP(9) + (size_t)l * DM * DFF2, DM, DFF2, (bf16_t*)(ws + W_UP), scr, r, lane); continue; } r -= I5;
                transpose_item(INP(12) + (size_t)l * DFF * DM, DFF, DM, (bf16_t*)(ws + W_DOWN), scr, r, lane);
            }
            if (l == 0) {
                const float* x = INP(0);
                for (int it = gt; it < M_TOK * DM / 8; it += NGT) {
                    const f32x4 a = *(const f32x4*)(x + (size_t)it * 8), c = *(const f32x4*)(x + (size_t)it * 8 + 4);
                    u32x4 o; o.x = cvtpk(a[0], a[1]); o.y = cvtpk(a[2], a[3]); o.z = cvtpk(c[0], c[1]); o.w = cvtpk(c[2], c[3]);
                    *(u32x4*)(XB + (size_t)it * 8) = o;
                }
            }
        } break;
        case 1: {
            pg8::SchedIN S{G, wg, (const char*)XB, (const char*)(ws + W_IN), ws};
            pg8::EpiBf16<0> E;
            pg8::gemm_phase(lds, tid, DM, 2048u, S, E);
        } break;
        case 2: {
            {
                LAS float* red = (LAS float*)lds;
                const bf16_t* KA = (const bf16_t*)(ws + B_KA);
                for (int it = wg; it < 256; it += G) {
                    const int b = it >> 7, j = (it >> 2) & 31, cgp = it & 3;
                    const int col = cgp * 128 + (tid & 127), rp = tid >> 7;
                    const bf16_t* src = KA + (size_t)(b * SEQ + j * 256 + rp * 64) * 512 + col;
                    float s = 0.f;
                    for (int rr = 0; rr < 64; ++rr) s += __uint_as_float((unsigned)src[(size_t)rr * 512] << 16);
                    __syncthreads();
                    red[tid] = s;
                    __syncthreads();
                    if (tid < 128) {
                        const float tot = (red[tid] + red[tid + 128]) + (red[tid + 256] + red[tid + 384]);
                        const int hh = col >> 6, d = col & 63;
                        ((float*)(ws + WS_KMEAN))[(size_t)((b * 8 + hh) * 32 + j) * 64 + d] = tot * (1.0f / 256.0f);
                    }
                }
            }
            {
                bf16_t* BC = (bf16_t*)(ws + B_BC); const bf16_t* CCp = (const bf16_t*)(ws + B_CC); const bf16_t* HHp = (const bf16_t*)(ws + B_HH);
                const float* wsc = INP(2) + (size_t)l * 3 * 512;
                for (int it = gt; it < M_TOK * 64; it += NGT) {
                    const int row = it >> 6, c8 = (it & 63) * 8, tpos = row & (SEQ - 1);
                    float accv[8];
#pragma unroll
                    for (int e = 0; e < 8; ++e) accv[e] = 0.f;
#pragma unroll
                    for (int j = 0; j < 3; ++j) {
                        if (tpos >= j) {
                            const u32x4 cv = *(const u32x4*)(CCp + (size_t)(row - j) * 512 + c8), hv = *(const u32x4*)(HHp + (size_t)(row - j) * 512 + c8);
                            const f32x4 w0 = *(const f32x4*)(wsc + j * 512 + c8), w1 = *(const f32x4*)(wsc + j * 512 + c8 + 4);
                            accv[0] += w0[0] * bflo(cv.x) * bflo(hv.x); accv[1] += w0[1] * bfhi(cv.x) * bfhi(hv.x);
                            accv[2] += w0[2] * bflo(cv.y) * bflo(hv.y); accv[3] += w0[3] * bfhi(cv.y) * bfhi(hv.y);
                            accv[4] += w1[0] * bflo(cv.z) * bflo(hv.z); accv[5] += w1[1] * bfhi(cv.z) * bfhi(hv.z);
                            accv[6] += w1[2] * bflo(cv.w) * bflo(hv.w); accv[7] += w1[3] * bfhi(cv.w) * bfhi(hv.w);
                        }
                    }
                    const u32x4 bv = *(const u32x4*)(BC + (size_t)row * 512 + c8);
                    u32x4 o;
                    o.x = cvtpk(bflo(bv.x) * accv[0], bfhi(bv.x) * accv[1]); o.y = cvtpk(bflo(bv.y) * accv[2], bfhi(bv.y) * accv[3]);
                    o.z = cvtpk(bflo(bv.z) * accv[4], bfhi(bv.z) * accv[5]); o.w = cvtpk(bflo(bv.w) * accv[6], bfhi(bv.w) * accv[7]);
                    *(u32x4*)(BC + (size_t)row * 512 + c8) = o;
                }
            }
        } break;
        case 3: {
            for (int uidx = wg; uidx < 256; uidx += G) {
                const int bh = uidx >> 4, s = uidx & 15;
                moba_tile(ws, bh >> 3, bh & 7, s, wave, lane);
                moba_tile(ws, bh >> 3, bh & 7, 31 - s, wave, lane);
            }
            for (int t = gw; t < 6144; t += NGW) dil_tile(ws, t, lane);
        } break;
        case 4: {
            {
                const bf16_t* QD = (const bf16_t*)(ws + B_QD); const float* LSE = (const float*)(ws + WS_LSE); bf16_t* YD = (bf16_t*)(ws + B_YD);
                for (int it = gt; it < M_TOK * 32; it += NGT) {
                    const int row = it >> 5, hh = (it >> 3) & 3, d8 = (it & 7) * 8;
                    const float l0 = LSE[(size_t)row * 12 + hh], l1 = LSE[(size_t)row * 12 + 4 + hh], l2 = LSE[(size_t)row * 12 + 8 + hh];
                    const float mx = fmaxf(l0, fmaxf(l1, l2));
                    float e0 = __expf(l0 - mx), e1 = __expf(l1 - mx), e2 = __expf(l2 - mx);
                    const float inv = 1.0f / (e0 + e1 + e2); e0 *= inv; e1 *= inv; e2 *= inv;
                    const u32x4 a = *(const u32x4*)(QD + (size_t)row * 768 + hh * 64 + d8), bq = *(const u32x4*)(QD + (size_t)row * 768 + 256 + hh * 64 + d8),
                                c = *(const u32x4*)(QD + (size_t)row * 768 + 512 + hh * 64 + d8);
                    u32x4 o;
                    o.x = cvtpk(e0 * bflo(a.x) + e1 * bflo(bq.x) + e2 * bflo(c.x), e0 * bfhi(a.x) + e1 * bfhi(bq.x) + e2 * bfhi(c.x));
                    o.y = cvtpk(e0 * bflo(a.y) + e1 * bflo(bq.y) + e2 * bflo(c.y), e0 * bfhi(a.y) + e1 * bfhi(bq.y) + e2 * bfhi(c.y));
                    o.z = cvtpk(e0 * bflo(a.z) + e1 * bflo(bq.z) + e2 * bflo(c.z), e0 * bfhi(a.z) + e1 * bfhi(bq.z) + e2 * bfhi(c.z));
                    o.w = cvtpk(e0 * bflo(a.w) + e1 * bflo(bq.w) + e2 * bflo(c.w), e0 * bfhi(a.w) + e1 * bfhi(bq.w) + e2 * bfhi(c.w));
                    *(u32x4*)(YD + (size_t)row * 256 + hh * 64 + d8) = o;
                }
            }
            pg8::SchedSimple S{64, 12, G, wg, (const char*)XB, (size_t)256 * 2048, (const char*)(ws + W_IN) + (size_t)5376 * 2048, (size_t)256 * 2048, 2048u, (bf16_t*)(ws + B_G), 3072};
            pg8::EpiBf16<1> E;
            pg8::gemm_phase(lds, tid, DM, 2048u, S, E);
        } break;
        case 5: {
            bf16_t* MG = XB;
            { pg8::SchedSimple S{64, 4, G, wg, (const char*)(ws + B_QA), (size_t)256 * 1024, (const char*)(ws + W_MOBA), (size_t)256 * 1024, 1024u, MG, 1024};
              pg8::EpiMerge<true> E{(const bf16_t*)(ws + B_G), MG, 0}; pg8::gemm_phase(lds, tid, 512, 1024u, S, E); }
            { pg8::SchedSimple S{64, 4, G, wg, (const char*)(ws + B_BC), (size_t)256 * 1024, (const char*)(ws + W_CONV), (size_t)256 * 1024, 1024u, MG, 1024};
              pg8::EpiMerge<false> E{(const bf16_t*)(ws + B_G), MG, 1}; pg8::gemm_phase(lds, tid, 512, 1024u, S, E); }
            { pg8::SchedSimple S{64, 4, G, wg, (const char*)(ws + B_YD), (size_t)256 * 512, (const char*)(ws + W_DIL), (size_t)256 * 512, 512u, MG, 1024};
              pg8::EpiMerge<false> E{(const bf16_t*)(ws + B_G), MG, 2}; pg8::gemm_phase(lds, tid, 256, 512u, S, E); }
        } break;
        case 6: {
            pg8::SchedSimple S{64, 4, G, wg, (const char*)XB, (size_t)256 * 2048, (const char*)(ws + W_MIX), (size_t)256 * 2048, 2048u, nullptr, 0};
            pg8::EpiRes E{xres, outp};
            pg8::gemm_phase(lds, tid, DM, 2048u, S, E);
        } break;
        case 7: case 13: {
            const float* gam = INP(k == 7 ? 7 : 13) + (size_t)l * DM; const float* bet = INP(k == 7 ? 8 : 14) + (size_t)l * DM;
            for (int m = gw; m < M_TOK; m += NGW) {
                f32x4* xr = (f32x4*)(outp + (size_t)m * DM) + lane;
                f32x4 v[4]; float s = 0.f;
#pragma unroll
                for (int j = 0; j < 4; ++j) { v[j] = xr[64 * j]; s += (v[j][0] + v[j][1]) + (v[j][2] + v[j][3]); }
                const float mean = wave_sum(s) * (1.f / DM); float s2 = 0.f;
#pragma unroll
                for (int j = 0; j < 4; ++j) { v[j] = v[j] - mean; s2 += (v[j][0] * v[j][0] + v[j][1] * v[j][1]) + (v[j][2] * v[j][2] + v[j][3] * v[j][3]); }
                const float rstd = 1.f / sqrtf(wave_sum(s2) * (1.f / DM) + LN_EPS);
                u32x2* o8 = (u32x2*)(XB + (size_t)m * DM) + lane;
#pragma unroll
                for (int j = 0; j < 4; ++j) {
                    const f32x4 gg = *((const f32x4*)gam + lane + 64 * j), bb = *((const f32x4*)bet + lane + 64 * j);
                    const f32x4 y = v[j] * rstd * gg + bb;
                    xr[64 * j] = y;
                    u32x2 o; o.x = cvtpk(y[0], y[1]); o.y = cvtpk(y[2], y[3]); o8[64 * j] = o;
                }
            }
        } break;
        case 8: case 10: {
            const int bb = (k == 10);
            pg8::SchedSimple S{32, 22, G, wg, (const char*)XB + (size_t)bb * SEQ * 2048, (size_t)256 * 2048, (const char*)(ws + W_UP), (size_t)256 * 2048, 2048u, (bf16_t*)(ws + B_U), DFF2};
            pg8::EpiBf16<0> E;
            pg8::gemm_phase(lds, tid, DM, 2048u, S, E);
        } break;
        case 9: case 11: {
            const int bb = (k == 11);
            const bf16_t* U = (const bf16_t*)(ws + B_U); bf16_t* Hh = (bf16_t*)(ws + B_H) + (size_t)bb * SEQ * DFF;
            const float* wf = INP(10) + (size_t)l * 3 * DFF2; const float* bfc = INP(11) + (size_t)l * DFF2;
            for (int it = gt; it < SEQ * 352; it += NGT) {
                const int t = it / 352, c8 = (it % 352) * 8;
                float ga[8], va[8];
                { const f32x4 b0 = *(const f32x4*)(bfc + c8), b1 = *(const f32x4*)(bfc + c8 + 4), d0 = *(const f32x4*)(bfc + DFF + c8), d1 = *(const f32x4*)(bfc + DFF + c8 + 4);
#pragma unroll
                  for (int e = 0; e < 4; ++e) { ga[e] = b0[e]; ga[4 + e] = b1[e]; va[e] = d0[e]; va[4 + e] = d1[e]; } }
#pragma unroll
                for (int j = 0; j < 3; ++j) {
                    if (t >= j) {
                        const u32x4 ug = *(const u32x4*)(U + (size_t)(t - j) * DFF2 + c8), uv = *(const u32x4*)(U + (size_t)(t - j) * DFF2 + DFF + c8);
                        const f32x4 w0 = *(const f32x4*)(wf + j * DFF2 + c8), w1 = *(const f32x4*)(wf + j * DFF2 + c8 + 4);
                        const f32x4 x0 = *(const f32x4*)(wf + j * DFF2 + DFF + c8), x1 = *(const f32x4*)(wf + j * DFF2 + DFF + c8 + 4);
                        ga[0] += w0[0] * bflo(ug.x); ga[1] += w0[1] * bfhi(ug.x); ga[2] += w0[2] * bflo(ug.y); ga[3] += w0[3] * bfhi(ug.y);
                        ga[4] += w1[0] * bflo(ug.z); ga[5] += w1[1] * bfhi(ug.z); ga[6] += w1[2] * bflo(ug.w); ga[7] += w1[3] * bfhi(ug.w);
                        va[0] += x0[0] * bflo(uv.x); va[1] += x0[1] * bfhi(uv.x); va[2] += x0[2] * bflo(uv.y); va[3] += x0[3] * bfhi(uv.y);
                        va[4] += x1[0] * bflo(uv.z); va[5] += x1[1] * bfhi(uv.z); va[6] += x1[2] * bflo(uv.w); va[7] += x1[3] * bfhi(uv.w);
                    }
                }
                float hv[8];
#pragma unroll
                for (int e = 0; e < 8; ++e) hv[e] = ga[e] * fast_sigmoid(ga[e]) * va[e];
                u32x4 o; o.x = cvtpk(hv[0], hv[1]); o.y = cvtpk(hv[2], hv[3]); o.z = cvtpk(hv[4], hv[5]); o.w = cvtpk(hv[6], hv[7]);
                *(u32x4*)(Hh + (size_t)t * DFF + c8) = o;
            }
        } break;
        case 12: {
            pg8::SchedSimple S{64, 4, G, wg, (const char*)(ws + B_H), (size_t)256 * DFF * 2, (const char*)(ws + W_DOWN), (size_t)256 * DFF * 2, (unsigned)(DFF * 2), nullptr, 0};
            pg8::EpiRes E{outp, outp};
            pg8::gemm_phase(lds, tid, DFF, (unsigned)(DFF * 2), S, E);
        } break;
        default: break;
        }
        if (ph + 1 < P.ph_hi) grid.sync();
    }
}

constexpr int LDS_BYTES = 131072 + 1024;

extern "C" void kernel_launch(void* const* d_in, const int* in_sizes, int n_in, void* d_out, int out_size, void* d_ws, size_t ws_size, hipStream_t stream) {
    static int grid = 0;
    if (grid == 0) {
        if (n_in != 15 || out_size != M_TOK * DM || ws_size < WS_NEED) { fprintf(stderr, "kernel_launch: unexpected shapes (n_in %d out %d ws %zu need %zu)\n", n_in, out_size, ws_size, (size_t)WS_NEED); grid = -1; return; }
        int dev = 0, cus = 0, per_cu = 0;
        hipGetDevice(&dev);
        hipDeviceGetAttribute(&cus, hipDeviceAttributeMultiprocessorCount, dev);
        hipFuncSetAttribute((const void*)mega_fwd, hipFuncAttributeMaxDynamicSharedMemorySize, LDS_BYTES);
        hipOccupancyMaxActiveBlocksPerMultiprocessor(&per_cu, (const void*)mega_fwd, 512, LDS_BYTES);
        if (per_cu < 1) { fprintf(stderr, "kernel_launch: occupancy query says %d blocks/CU\n", per_cu); per_cu = 1; }
        grid = cus;
        (void)hipGetLastError();
    }
    if (grid < 0) return;
    Params p{};
    for (int i = 0; i < 15; ++i) p.in[i] = (const float*)d_in[i];
    p.out = (float*)d_out; p.ws = (unsigned char*)d_ws;
#ifndef MK_SPLIT
    p.ph_lo = 0; p.ph_hi = NPH;
    void* args[] = {&p};
    hipError_t e = hipLaunchCooperativeKernel((const void*)mega_fwd, dim3(grid), dim3(512), args, LDS_BYTES, stream);
    if (e != hipSuccess) fprintf(stderr, "cooperative launch failed: %s (grid %d)\n", hipGetErrorString(e), grid);
#else
    for (int ph = 0; ph < NPH; ++ph) {
        p.ph_lo = ph; p.ph_hi = ph + 1;
        void* args[] = {&p};
        hipError_t e = hipLaunchCooperativeKernel((const void*)mega_fwd, dim3(grid), dim3(512), args, LDS_BYTES, stream);
        if (e != hipSuccess) { fprintf(stderr, "launch %d failed: %s\n", ph, hipGetErrorString(e)); break; }
    }
#endif
}
```

```cpp
#include <hip/hip_runtime.h>
#include <hip/hip_cooperative_groups.h>
#include <cstdio>
#include <cstdint>
namespace cg = cooperative_groups;

#define LAS __attribute__((address_space(3)))
#define GAS __attribute__((address_space(1)))
typedef unsigned short bf16_t;
typedef short bf16x8 __attribute__((ext_vector_type(8)));
typedef short s16x4 __attribute__((ext_vector_type(4)));
typedef float f32x4 __attribute__((ext_vector_type(4)));
typedef float f32x16 __attribute__((ext_vector_type(16)));
typedef unsigned u32x4 __attribute__((ext_vector_type(4)));
typedef unsigned u32x2 __attribute__((ext_vector_type(2)));
typedef float f32x2_t __attribute__((ext_vector_type(2)));
typedef __bf16 bf16x2_t __attribute__((ext_vector_type(2)));

constexpr int M_TOK = 16384, SEQ = 8192, DM = 1024, INC = 8448, DFF = 2816, DFF2 = 5632;
constexpr float LN_EPS = 1e-5f;
constexpr float DN_ALPHA = 1.41421356237f;
constexpr int NPH_LAYER = 14, NPH = 2 * NPH_LAYER;

constexpr size_t MiB = 1u << 20;
constexpr size_t W_IN = 1 * MiB;
constexpr size_t W_MOBA = W_IN + (size_t)INC * DM * 2;
constexpr size_t W_CONV = W_MOBA + 1024 * 512 * 2;
constexpr size_t W_DIL = W_CONV + 1024 * 512 * 2;
constexpr size_t W_MIX = W_DIL + 1024 * 256 * 2;
constexpr size_t W_UP = W_MIX + 1024 * 1024 * 2;
constexpr size_t W_DOWN = W_UP + (size_t)DFF2 * DM * 2;
constexpr size_t W_END = W_DOWN + (size_t)DM * DFF * 2;
constexpr size_t WS_XB = W_END;
constexpr size_t WS_KMEAN = WS_XB + 32 * MiB;
constexpr size_t WS_LSE = WS_KMEAN + 131072;
constexpr size_t WS_BIG = WS_KMEAN + 1 * MiB;
constexpr size_t B_QA = WS_BIG, B_BC = B_QA + 16 * MiB, B_QD = B_BC + 16 * MiB, B_YD = B_QD + 24 * MiB, B_KA = B_YD + 8 * MiB,
                 B_VTA = B_KA + 16 * MiB, B_KD = B_VTA + 16 * MiB, B_VTD = B_KD + 24 * MiB, B_CC = B_VTD + 24 * MiB, B_HH = B_CC + 16 * MiB,
                 B_END = B_HH + 16 * MiB;
constexpr size_t B_G = B_KA;
constexpr size_t B_U = WS_BIG;
constexpr size_t B_H = WS_BIG + 88 * MiB;
constexpr size_t WS_NEED = B_END;
static_assert(W_END % 256 == 0 && B_G + 96 * MiB <= B_HH && B_H + 88 * MiB <= B_END, "ws map");

__device__ __forceinline__ unsigned cvtpk(float lo, float hi) { f32x2_t v = {lo, hi}; bf16x2_t b = __builtin_convertvector(v, bf16x2_t); return __builtin_bit_cast(unsigned, b); }
__device__ __forceinline__ float bflo(unsigned w) { return __uint_as_float(w << 16); }
__device__ __forceinline__ float bfhi(unsigned w) { return __uint_as_float(w & 0xffff0000u); }
__device__ __forceinline__ float fast_sigmoid(float x) { return __builtin_amdgcn_rcpf(1.0f + __builtin_amdgcn_exp2f(-1.44269504089f * x)); }

namespace pg8 {
constexpr int BM = 256, BK = 64, HALF = 128, HTB = HALF * BK * 2, STAGE_BYTES = 8 * HTB, NXCD = 8, WGM = 8;
__host__ __device__ __forceinline__ int lds_byte(int r, int c) { const int st = (r >> 4) * 2 + (c >> 5), rr = r & 15, cc = c & 31, ob = rr * 64 + cc * 2; return st * 1024 + (ob ^ (((ob >> 9) & 1) << 5)); }
__host__ __device__ __forceinline__ void stage_rc(int b, int& R, int& C) { const int st = b / 1024, sb = b % 1024, swz = sb ^ (((sb >> 9) & 1) << 5); R = (st >> 1) * 16 + swz / 64; C = (st & 1) * 32 + (swz % 64) / 2; }
__host__ __device__ __forceinline__ int perm32(int rho) { const int n = rho >> 4, i = rho & 15; return 8 * (i >> 2) + 4 * n + (i & 3); }

struct GUnit { const char* A; const char* B; unsigned ldb; bf16_t* O; int ldc; int r0, c0; };

__device__ __forceinline__ void tile_order(int wgid, int nM, int nN, int& pm, int& pn) {
    const int nwg = nM * nN;
    { const int q = nwg / NXCD, r = nwg % NXCD, xcd = wgid % NXCD, off = wgid / NXCD; wgid = (xcd < r ? xcd * (q + 1) : r * (q + 1) + (xcd - r) * q) + off; }
    const int nig = WGM * nN, gid = wgid / nig, fm = gid * WGM, gsz = (nM - fm) < WGM ? (nM - fm) : WGM;
    pm = fm + ((wgid % nig) % gsz); pn = (wgid % nig) / gsz;
}

template <class Sched, class Epi>
__device__ __forceinline__ void gemm_phase(LAS unsigned char* lds, const int tid, const int K, const unsigned lda, const Sched& S, const Epi& E) {
    const int wid = __builtin_amdgcn_readfirstlane(tid >> 6), lane = tid & 63, wr = wid >> 2, wc = wid & 3, fr = lane & 15, fq = lane >> 4;
    const int nt = K / BK;
    unsigned voffA[2], RB[2], CC2[2];
#pragma unroll
    for (int i = 0; i < 2; ++i) { int R, C; stage_rc(tid * 16 + i * 8192, R, C); const int Rb = (R & ~31) + perm32(R & 31);
        voffA[i] = (unsigned)R * lda + (unsigned)C * 2u; RB[i] = (unsigned)Rb; CC2[i] = (unsigned)C * 2u; }
    const size_t kstep = (size_t)(BK * 2);
    const size_t hstepA = (size_t)HALF * lda;
    const unsigned ldsw = (unsigned)wid * 1024u;
    const int aoff = lds_byte(wr * 64 + fr, fq * 8), boff = lds_byte(wc * 32 + fr, fq * 8);
#define PG8_SA(b, h) (((b) * 2 + (h)) * HTB)
#define PG8_SB(b, h) ((4 + (b) * 2 + (h)) * HTB)
#define PG8_STAGE(bufoff, gbase, voff) do { _Pragma("unroll") for (int _i = 0; _i < 2; ++_i) \
        __builtin_amdgcn_global_load_lds((const unsigned*)((const char*)(gbase) + (voff)[_i]), (LAS unsigned*)(lds + (bufoff) + ldsw + _i * 8192), 16, 0, 0); } while (0)
#define PG8_LDA(dst, b, h) do { _Pragma("unroll") for (int m = 0; m < 4; ++m) _Pragma("unroll") for (int k = 0; k < 2; ++k) dst[m][k] = *(const LAS bf16x8*)(lds + PG8_SA(b, h) + aoff + m * 2048 + k * 1024); } while (0)
#define PG8_LDB(dst, b, h) do { _Pragma("unroll") for (int n = 0; n < 2; ++n) _Pragma("unroll") for (int k = 0; k < 2; ++k) dst[n][k] = *(const LAS bf16x8*)(lds + PG8_SB(b, h) + boff + n * 2048 + k * 1024); } while (0)
#define PG8_MMA(ai, bj, At, Bt) do { __builtin_amdgcn_s_setprio(1); _Pragma("unroll") for (int m = 0; m < 4; ++m) _Pragma("unroll") for (int n = 0; n < 2; ++n) _Pragma("unroll") for (int k = 0; k < 2; ++k) \
        acc[ai][bj][m][n] = __builtin_amdgcn_mfma_f32_16x16x32_bf16(Bt[n][k], At[m][k], acc[ai][bj][m][n], 0, 0, 0); __builtin_amdgcn_s_setprio(0); } while (0)
#define PG8_WAIT_V(n) asm volatile("s_waitcnt vmcnt(" #n ")" ::: "memory")
#define PG8_WAIT_L(n) asm volatile("s_waitcnt lgkmcnt(" #n ")" ::: "memory")
#define PG8_BAR __builtin_amdgcn_s_barrier()
#define PG8_SCHED __builtin_amdgcn_sched_barrier(0)
    GUnit cur, nxt; int ui = 0;
    if (!S.next(0, cur)) return;
    f32x4 acc[2][2][4][2];
#pragma unroll
    for (int a = 0; a < 2; ++a)
#pragma unroll
        for (int b = 0; b < 2; ++b)
#pragma unroll
            for (int m = 0; m < 4; ++m)
#pragma unroll
                for (int n = 0; n < 2; ++n) acc[a][b][m][n] = (f32x4){0.f, 0.f, 0.f, 0.f};
    bf16x8 At[4][2], B0[2][2], B1[2][2];
    const char* cA = cur.A; const char* cB = cur.B;
    unsigned vBc[2] = {RB[0] * cur.ldb + CC2[0], RB[1] * cur.ldb + CC2[1]};
    size_t hBc = (size_t)HALF * cur.ldb;
    PG8_STAGE(PG8_SB(0, 0), cB, vBc); PG8_STAGE(PG8_SB(0, 1), cB + hBc, vBc); PG8_STAGE(PG8_SA(0, 0), cA, voffA); PG8_STAGE(PG8_SA(0, 1), cA + hstepA, voffA);
    if (wr == 1) PG8_BAR;
    PG8_WAIT_V(2); PG8_BAR;
    PG8_STAGE(PG8_SB(1, 0), cB + kstep, vBc); PG8_STAGE(PG8_SA(1, 0), cA + kstep, voffA); PG8_STAGE(PG8_SB(1, 1), cB + hBc + kstep, vBc);
    PG8_WAIT_V(6); PG8_BAR;
    for (;;) {
        const bool has_next = S.next(ui + 1, nxt);
        const char* nA = has_next ? nxt.A : cA; const char* nB = has_next ? nxt.B : cB;
        const unsigned nldb = has_next ? nxt.ldb : cur.ldb;
        unsigned vBn[2] = {RB[0] * nldb + CC2[0], RB[1] * nldb + CC2[1]};
        const size_t hBn = (size_t)HALF * nldb;
        for (int t = 0; t < nt; t += 2) {
            const bool last = (t == nt - 2);
            const char* a1 = cA + (size_t)(t + 1) * kstep;
            const char* a2 = last ? nA : cA + (size_t)(t + 2) * kstep; const char* b2 = last ? nB : cB + (size_t)(t + 2) * kstep;
            const char* a3 = a2 + kstep; const char* b3 = b2 + kstep;
            unsigned vB[2] = {last ? vBn[0] : vBc[0], last ? vBn[1] : vBc[1]};
            const size_t hB = last ? hBn : hBc;
            PG8_LDB(B0, 0, 0); PG8_LDB(B1, 0, 1); PG8_SCHED; PG8_LDA(At, 0, 0); PG8_STAGE(PG8_SA(1, 1), a1 + hstepA, voffA);
            PG8_WAIT_V(8); PG8_WAIT_L(0); PG8_BAR; PG8_MMA(0, 0, At, B0); PG8_MMA(0, 1, At, B1); PG8_BAR; PG8_SCHED;
            PG8_LDA(At, 0, 1); PG8_STAGE(PG8_SB(0, 0), b2, vB); PG8_STAGE(PG8_SB(0, 1), b2 + hB, vB); PG8_STAGE(PG8_SA(0, 0), a2, voffA);
            PG8_WAIT_V(8); PG8_WAIT_L(0); PG8_BAR; PG8_MMA(1, 0, At, B0); PG8_MMA(1, 1, At, B1); PG8_BAR; PG8_SCHED;
            PG8_LDB(B0, 1, 0); PG8_LDB(B1, 1, 1); PG8_SCHED; PG8_LDA(At, 1, 0); PG8_STAGE(PG8_SA(0, 1), a2 + hstepA, voffA);
            PG8_WAIT_V(8); PG8_WAIT_L(0); PG8_BAR; PG8_MMA(0, 0, At, B0); PG8_MMA(0, 1, At, B1); PG8_BAR; PG8_SCHED;
            PG8_LDA(At, 1, 1); PG8_STAGE(PG8_SB(1, 0), b3, vB); PG8_STAGE(PG8_SB(1, 1), b3 + hB, vB); PG8_STAGE(PG8_SA(1, 0), a3, voffA);
            PG8_WAIT_V(8); PG8_WAIT_L(0); PG8_BAR; PG8_MMA(1, 0, At, B0); PG8_MMA(1, 1, At, B1); PG8_BAR; PG8_SCHED;
        }
        if (wr == 0) PG8_BAR;
        E(acc, cur, wr, wc, fr, fq);
        if (!has_next) break;
#pragma unroll
        for (int a = 0; a < 2; ++a)
#pragma unroll
            for (int b = 0; b < 2; ++b)
#pragma unroll
                for (int m = 0; m < 4; ++m)
#pragma unroll
                    for (int n = 0; n < 2; ++n) acc[a][b][m][n] = (f32x4){0.f, 0.f, 0.f, 0.f};
        cur = nxt; cA = nA; cB = nB; vBc[0] = vBn[0]; vBc[1] = vBn[1]; hBc = hBn; ++ui;
        if (wr == 1) PG8_BAR;
    }
    PG8_WAIT_V(0);
    PG8_BAR;
#undef PG8_SA
#undef PG8_SB
#undef PG8_STAGE
#undef PG8_LDA
#undef PG8_LDB
#undef PG8_MMA
#undef PG8_WAIT_V
#undef PG8_WAIT_L
#undef PG8_BAR
#undef PG8_SCHED
}

template <int ACT> struct EpiBf16 {
    __device__ __forceinline__ void operator()(const f32x4 (&acc)[2][2][4][2], const GUnit& u, int wr, int wc, int fr, int fq) const {
#pragma unroll
        for (int ai = 0; ai < 2; ++ai)
#pragma unroll
            for (int m = 0; m < 4; ++m) {
                const int row = u.r0 + ai * HALF + wr * 64 + m * 16 + fr;
                bf16_t* rowp = u.O + (size_t)row * u.ldc + u.c0 + wc * 32 + 8 * fq;
#pragma unroll
                for (int bj = 0; bj < 2; ++bj) {
                    f32x4 v0 = acc[ai][bj][m][0], v1 = acc[ai][bj][m][1];
                    if (ACT == 1) {
#pragma unroll
                        for (int k = 0; k < 4; ++k) { v0[k] = fast_sigmoid(v0[k]); v1[k] = fast_sigmoid(v1[k]); }
                    }
                    u32x4 w; w.x = cvtpk(v0[0], v0[1]); w.y = cvtpk(v0[2], v0[3]); w.z = cvtpk(v1[0], v1[1]); w.w = cvtpk(v1[2], v1[3]);
                    *(u32x4*)(rowp + bj * HALF) = w;
                }
            }
    }
};
template <bool FIRST> struct EpiMerge {
    const bf16_t* G; bf16_t* Mg; int gi;
    __device__ __forceinline__ void operator()(const f32x4 (&acc)[2][2][4][2], const GUnit& u, int wr, int wc, int fr, int fq) const {
#pragma unroll
        for (int ai = 0; ai < 2; ++ai)
#pragma unroll
            for (int m = 0; m < 4; ++m) {
                const int row = u.r0 + ai * HALF + wr * 64 + m * 16 + fr;
#pragma unroll
                for (int bj = 0; bj < 2; ++bj) {
                    const int col = u.c0 + bj * HALF + wc * 32 + 8 * fq;
                    const u32x4 g = *(const u32x4*)(G + (size_t)row * 3072 + gi * 1024 + col);
                    bf16_t* mp = Mg + (size_t)row * 1024 + col;
                    u32x4 o = (u32x4){0u, 0u, 0u, 0u};
                    if (!FIRST) o = *(const u32x4*)mp;
                    const f32x4 v0 = acc[ai][bj][m][0], v1 = acc[ai][bj][m][1];
                    u32x4 w;
                    w.x = cvtpk(bflo(g.x) * v0[0] + bflo(o.x), bfhi(g.x) * v0[1] + bfhi(o.x));
                    w.y = cvtpk(bflo(g.y) * v0[2] + bflo(o.y), bfhi(g.y) * v0[3] + bfhi(o.y));
                    w.z = cvtpk(bflo(g.z) * v1[0] + bflo(o.z), bfhi(g.z) * v1[1] + bfhi(o.z));
                    w.w = cvtpk(bflo(g.w) * v1[2] + bflo(o.w), bfhi(g.w) * v1[3] + bfhi(o.w));
                    *(u32x4*)mp = w;
                }
            }
    }
};
struct EpiRes {
    const float* base; float* out;
    __device__ __forceinline__ void operator()(const f32x4 (&acc)[2][2][4][2], const GUnit& u, int wr, int wc, int fr, int fq) const {
#pragma unroll
        for (int ai = 0; ai < 2; ++ai)
#pragma unroll
            for (int m = 0; m < 4; ++m) {
                const int row = u.r0 + ai * HALF + wr * 64 + m * 16 + fr;
#pragma unroll
                for (int bj = 0; bj < 2; ++bj) {
                    const size_t off = (size_t)row * 1024 + u.c0 + bj * HALF + wc * 32 + 8 * fq;
                    const f32x4 b0 = *(const f32x4*)(base + off), b1 = *(const f32x4*)(base + off + 4);
                    *(f32x4*)(out + off) = b0 * DN_ALPHA + acc[ai][bj][m][0];
                    *(f32x4*)(out + off + 4) = b1 * DN_ALPHA + acc[ai][bj][m][1];
                }
            }
    }
};

struct SchedSimple {
    int nM, nN, G, c; const char* A; size_t a_tile; const char* B; size_t b_tile; unsigned ldb; bf16_t* O; int ldc;
    __device__ __forceinline__ bool next(int i, GUnit& u) const {
        const long L = (long)i * G + c; if (L >= (long)nM * nN) return false;
        int pm, pn; tile_order((int)L, nM, nN, pm, pn);
        u.A = A + (size_t)pm * a_tile; u.B = B + (size_t)pn * b_tile; u.ldb = ldb; u.O = O; u.ldc = ldc; u.r0 = pm * 256; u.c0 = pn * 256; return true;
    }
};
struct SchedIN {
    int G, c; const char* xb; const char* wt; unsigned char* ws;
    __device__ __forceinline__ bool next(int i, GUnit& u) const {
        const long L = (long)i * G + c; if (L >= 1344) return false;
        if (L < 1024) {
            int pm, pn; tile_order((int)L, 64, 16, pm, pn);
            const int wtile = pn < 4 ? pn : (pn < 10 ? pn + 2 : pn + 5);
            u.A = xb + (size_t)pm * 256 * 2048; u.B = wt + (size_t)wtile * 256 * 2048; u.ldb = 2048; u.r0 = pm * 256;
            size_t sec; int ct, ldc = 512;
            if (wtile < 2) { sec = B_QA; ct = wtile; }
            else if (wtile < 4) { sec = B_KA; ct = wtile - 2; }
            else if (wtile < 9) { sec = B_QD; ct = wtile - 6; ldc = 768; }
            else if (wtile < 12) { sec = B_KD; ct = wtile - 9; ldc = 768; }
            else if (wtile < 17) { sec = B_BC; ct = wtile - 15; }
            else if (wtile < 19) { sec = B_CC; ct = wtile - 17; }
            else { sec = B_HH; ct = wtile - 19; }
            u.O = (bf16_t*)(ws + sec); u.ldc = ldc; u.c0 = ct * 256;
        } else {
            const int v = (int)L - 1024, sub = v >> 6, it = v & 63;
            u.ldc = 16384; u.c0 = it * 256;
            if (sub < 2) {
                u.A = wt + (size_t)(1024 + 256 * sub) * 2048; u.B = xb + (size_t)it * 256 * 2048; u.ldb = 2048; u.O = (bf16_t*)(ws + B_VTA); u.r0 = 256 * sub;
            } else {
                const int g = sub - 2, r = 1 << (2 * g), b = it >> 5, idx = it & 31, per = 32 >> (2 * g), rho = idx / per, p0 = (idx % per) * 256;
                u.A = wt + (size_t)(3072 + 256 * g) * 2048; u.B = xb + (size_t)(b * SEQ + p0 * r + rho) * 2048; u.ldb = 2048u * (unsigned)r;
                u.O = (bf16_t*)(ws + B_VTD); u.r0 = 256 * g;
            }
        }
        return true;
    }
};
}

__device__ __forceinline__ int crow(int r, int hi) { return (r & 3) + 8 * (r >> 2) + 4 * hi; }
struct AttnSt { f32x16 o0, o1; float m, l; };
struct Frags { bf16x8 k[4]; s16x4 v0[4]; s16x4 v1[4]; };

__device__ __forceinline__ void load_frags(Frags& f, const bf16_t* kp, const bf16_t* v0p, const bf16_t* v1p) {
#pragma unroll
    for (int d0 = 0; d0 < 4; ++d0) f.k[d0] = *(const bf16x8*)(kp + 16 * d0);
#pragma unroll
    for (int j = 0; j < 4; ++j) { f.v0[j] = *(const s16x4*)(v0p + 8 * j); f.v1[j] = *(const s16x4*)(v1p + 8 * j); }
}
#define CAT8(a, b) (bf16x8){a[0], a[1], a[2], a[3], b[0], b[1], b[2], b[3]}
__device__ __forceinline__ void attn_step(AttnSt& st, const bf16x8 (&qf)[4], const Frags& f, int kvbase, int hi, int lo_b, int hi_b) {
    f32x16 p;
#pragma unroll
    for (int r = 0; r < 16; ++r) p[r] = 0.f;
#pragma unroll
    for (int d0 = 0; d0 < 4; ++d0) p = __builtin_amdgcn_mfma_f32_32x32x16_bf16(f.k[d0], qf[d0], p, 0, 0, 0);
    const float C2 = 0.125f * 1.44269504089f;
    float mx = -INFINITY;
#pragma unroll
    for (int r = 0; r < 16; ++r) { const int kv = kvbase + crow(r, hi); float s = p[r] * C2; s = (kv >= lo_b && kv <= hi_b) ? s : -INFINITY; p[r] = s; mx = fmaxf(mx, s); }
    mx = fmaxf(mx, __shfl_xor(mx, 32));
    const float mn = fmaxf(st.m, mx);
    const float alpha = __builtin_amdgcn_exp2f(st.m - mn);
    float ps = 0.f;
#pragma unroll
    for (int r = 0; r < 16; ++r) { p[r] = __builtin_amdgcn_exp2f(p[r] - mn); ps += p[r]; }
    st.l = st.l * alpha + ps; st.m = mn;
#pragma unroll
    for (int r = 0; r < 16; ++r) { st.o0[r] *= alpha; st.o1[r] *= alpha; }
    u32x4 wa, wb;
    wa.x = cvtpk(p[0], p[1]); wa.y = cvtpk(p[2], p[3]); wa.z = cvtpk(p[4], p[5]); wa.w = cvtpk(p[6], p[7]);
    wb.x = cvtpk(p[8], p[9]); wb.y = cvtpk(p[10], p[11]); wb.z = cvtpk(p[12], p[13]); wb.w = cvtpk(p[14], p[15]);
    const bf16x8 pa = __builtin_bit_cast(bf16x8, wa), pb = __builtin_bit_cast(bf16x8, wb);
    st.o0 = __builtin_amdgcn_mfma_f32_32x32x16_bf16(CAT8(f.v0[0], f.v0[1]), pa, st.o0, 0, 0, 0);
    st.o0 = __builtin_amdgcn_mfma_f32_32x32x16_bf16(CAT8(f.v0[2], f.v0[3]), pb, st.o0, 0, 0, 0);
    st.o1 = __builtin_amdgcn_mfma_f32_32x32x16_bf16(CAT8(f.v1[0], f.v1[1]), pa, st.o1, 0, 0, 0);
    st.o1 = __builtin_amdgcn_mfma_f32_32x32x16_bf16(CAT8(f.v1[2], f.v1[3]), pb, st.o1, 0, 0, 0);
}
__device__ __forceinline__ void attn_init(AttnSt& st) {
#pragma unroll
    for (int r = 0; r < 16; ++r) { st.o0[r] = 0.f; st.o1[r] = 0.f; }
    st.m = -1e30f; st.l = 0.f;
}
__device__ __forceinline__ float attn_store(const AttnSt& st, bf16_t* orow, int hi, bool dry = false) {
    const float lt = st.l + __shfl_xor(st.l, 32);
    const float inv = 1.0f / lt;
    if (dry && lt > -1.0f) return lt;
#pragma unroll
    for (int g4 = 0; g4 < 4; ++g4) {
        u32x2 a, b;
        a.x = cvtpk(st.o0[4 * g4] * inv, st.o0[4 * g4 + 1] * inv); a.y = cvtpk(st.o0[4 * g4 + 2] * inv, st.o0[4 * g4 + 3] * inv);
        b.x = cvtpk(st.o1[4 * g4] * inv, st.o1[4 * g4 + 1] * inv); b.y = cvtpk(st.o1[4 * g4 + 2] * inv, st.o1[4 * g4 + 3] * inv);
        *(u32x2*)(orow + 8 * g4 + 4 * hi) = a;
        *(u32x2*)(orow + 32 + 8 * g4 + 4 * hi) = b;
    }
    return lt;
}

__device__ __forceinline__ void moba_tile(unsigned char* ws, int b, int h, int qblk, int w, int lane, bool dry = false) {
    const int l31 = lane & 31, hi = lane >> 5;
    const int q = qblk * 256 + w * 32 + l31;
    bf16_t* Qrow = (bf16_t*)(ws + B_QA) + (size_t)(b * SEQ + q) * 512 + h * 64;
    const bf16_t* Kl = (const bf16_t*)(ws + B_KA) + (size_t)(b * SEQ + l31) * 512 + h * 64 + 8 * hi;
    const bf16_t* V0 = (const bf16_t*)(ws + B_VTA) + (size_t)(h * 64 + l31) * 16384 + b * SEQ + 4 * hi;
    const bf16_t* V1 = V0 + (size_t)32 * 16384;
    unsigned mask = 0u;
    if (qblk > 0) {
        float qv[32];
#pragma unroll
        for (int c4 = 0; c4 < 4; ++c4) { const u32x4 t = *(const u32x4*)(Qrow + 32 * hi + 8 * c4);
            qv[8 * c4 + 0] = bflo(t.x); qv[8 * c4 + 1] = bfhi(t.x); qv[8 * c4 + 2] = bflo(t.y); qv[8 * c4 + 3] = bfhi(t.y);
            qv[8 * c4 + 4] = bflo(t.z); qv[8 * c4 + 5] = bfhi(t.z); qv[8 * c4 + 6] = bflo(t.w); qv[8 * c4 + 7] = bfhi(t.w); }
        const float* km = (const float*)(ws + WS_KMEAN) + (size_t)((b * 8 + h) * 32) * 64 + 32 * hi;
        float g[32];
#pragma unroll
        for (int j = 0; j < 32; ++j) {
            float s = 0.f;
            if (j < qblk) {
#pragma unroll
                for (int d4 = 0; d4 < 8; ++d4) { const f32x4 kk = *(const f32x4*)(km + j * 64 + 4 * d4);
                    s += qv[4 * d4] * kk[0] + qv[4 * d4 + 1] * kk[1] + qv[4 * d4 + 2] * kk[2] + qv[4 * d4 + 3] * kk[3]; }
            }
            g[j] = s + __shfl_xor(s, 32);
        }
#pragma unroll
        for (int pass = 0; pass < 3; ++pass) {
            float best = -INFINITY; int bi = -1;
#pragma unroll
            for (int j = 0; j < 32; ++j) { const bool ok = (j < qblk) && !((mask >> j) & 1u) && (g[j] > best); best = ok ? g[j] : best; bi = ok ? j : bi; }
            if (bi >= 0) mask |= 1u << bi;
        }
    }
    unsigned need = 0u;
    for (int j = 0; j < qblk; ++j) if (__any((int)((mask >> j) & 1u))) need |= 1u << j;
    need |= 1u << qblk;
    bf16x8 qf[4];
#pragma unroll
    for (int d0 = 0; d0 < 4; ++d0) qf[d0] = *(const bf16x8*)(Qrow + 16 * d0 + 8 * hi);
    AttnSt st; attn_init(st);
    int blk = __builtin_ctz(need); need &= need - 1u; int i = 0;
    Frags f, fn;
    { const int kv = blk * 256; load_frags(f, Kl + (size_t)kv * 512, V0 + kv, V1 + kv); }
    for (;;) {
        const int nst = (blk == qblk) ? (w + 1) : 8;
        int nblk = blk, ni = i + 1; bool has = true;
        if (ni >= nst) { if (need == 0u) has = false; else { nblk = __builtin_ctz(need); need &= need - 1u; ni = 0; } }
        if (has) { const int kv = nblk * 256 + ni * 32; load_frags(fn, Kl + (size_t)kv * 512, V0 + kv, V1 + kv); }
        const bool own = (blk == qblk);
        const bool sel = own || ((mask >> blk) & 1u);
        const int lo_b = sel ? -1 : 0x7fffffff, hi_b = own ? q : 0x7ffffff0;
        attn_step(st, qf, f, blk * 256 + i * 32, hi, lo_b, hi_b);
        if (!has) break;
        f = fn; blk = nblk; i = ni;
    }
    attn_store(st, Qrow, hi, dry);
}

__device__ __forceinline__ void dil_tile(unsigned char* ws, int tile, int lane, bool dry = false) {
    const int l31 = lane & 31, hi = lane >> 5;
    const int b = tile / 3072, rem = tile % 3072, hd = rem >> 8, t = rem & 255, g = hd >> 2, sh = 2 * g, r = 1 << sh;
    const int len = SEQ >> sh, tpr = len >> 5, rho = t / tpr, p0 = (t % tpr) * 32;
    const int p = p0 + l31, tok = p * r + rho;
    bf16_t* Qrow = (bf16_t*)(ws + B_QD) + (size_t)(b * SEQ + tok) * 768 + hd * 64;
    const bf16_t* Kl = (const bf16_t*)(ws + B_KD) + (size_t)(b * SEQ + rho) * 768 + hd * 64 + 8 * hi;
    const bf16_t* V0 = (const bf16_t*)(ws + B_VTD) + (size_t)(hd * 64 + l31) * 16384 + b * SEQ + rho * len + 4 * hi;
    const bf16_t* V1 = V0 + (size_t)32 * 16384;
    bf16x8 qf[4];
#pragma unroll
    for (int d0 = 0; d0 < 4; ++d0) qf[d0] = *(const bf16x8*)(Qrow + 16 * d0 + 8 * hi);
    AttnSt st; attn_init(st);
    int s = (p0 >= 128) ? 0 : ((128 - p0) >> 5);
    Frags f, fn;
    { const int kv = p0 - 128 + 32 * s; load_frags(f, Kl + (size_t)((kv + l31) * r) * 768, V0 + kv, V1 + kv); }
    for (;;) {
        const bool has = (s + 1) < 5;
        if (has) { const int kv = p0 - 128 + 32 * (s + 1); load_frags(fn, Kl + (size_t)((kv + l31) * r) * 768, V0 + kv, V1 + kv); }
        attn_step(st, qf, f, p0 - 128 + 32 * s, hi, p - 128, p);
        if (!has) break;
        f = fn; ++s;
    }
    const float lt = attn_store(st, Qrow, hi, dry);
    if (hi == 0 && !dry) ((float*)(ws + WS_LSE))[(size_t)(b * SEQ + tok) * 12 + hd] = 0.69314718056f * (st.m + __builtin_amdgcn_logf(lt));
}

__device__ __forceinline__ float wave_sum(float v) {
#pragma unroll
    for (int o = 1; o < 64; o <<= 1) v += __shfl_xor(v, o);
    return v;
}
__device__ __forceinline__ void transpose_item(const float* W, int K, int N, bf16_t* WT, LAS float* scr, int item, int lane) {
    const int nblk = N / 32, kb = item / nblk, nb = item % nblk, k0 = 64 * kb, n0 = 32 * nb;
#pragma unroll 8
    for (int i = 0; i < 32; ++i) { const int kk = 2 * i + (lane >> 5); scr[kk * 33 + (lane & 31)] = W[(size_t)(k0 + kk) * N + n0 + (lane & 31)]; }
    asm volatile("s_waitcnt lgkmcnt(0)" ::: "memory");
    const int c = lane & 7;
#pragma unroll
    for (int j = 0; j < 4; ++j) { const int n = (lane >> 3) + 8 * j; const LAS float* s = scr + (8 * c) * 33 + n;
        u32x4 o; o.x = cvtpk(s[0 * 33], s[1 * 33]); o.y = cvtpk(s[2 * 33], s[3 * 33]); o.z = cvtpk(s[4 * 33], s[5 * 33]); o.w = cvtpk(s[6 * 33], s[7 * 33]);
        *(u32x4*)(WT + (size_t)(n0 + n) * K + k0 + 8 * c) = o; }
    asm volatile("s_waitcnt lgkmcnt(0)" ::: "memory");
}

#define XB_TMO      128
#define XB_XCNT(j)  (256  + 64 * (j))
#define XB_XSUB(j)  (1280 + 64 * (j))
#define XB_XGEN(j)  (2304 + 64 * (j))
#define XB_TOP      3328
#define XB_TOPGEN   3392
#define XCD_BAR_WORDS 3456
#define XB_SPIN_CAP (1u << 22)
__device__ __forceinline__ unsigned xb_ld(unsigned* p)              { return __hip_atomic_load(p, __ATOMIC_RELAXED, __HIP_MEMORY_SCOPE_AGENT); }
__device__ __forceinline__ unsigned xb_add(unsigned* p, unsigned v) { return __hip_atomic_fetch_add(p, v, __ATOMIC_RELAXED, __HIP_MEMORY_SCOPE_AGENT); }
__device__ __forceinline__ unsigned xb_xcc_id() { return (unsigned)__builtin_amdgcn_s_getreg((3 << 11) | 20) & 0xFu; }
#define XB_SPIN(cond, bar) do { unsigned _sp = 0; while (cond) { __builtin_amdgcn_s_sleep(1); \
    if ((++_sp & 255u) == 0u) { if (xb_ld(&(bar)[XB_TMO])) break; if (_sp > XB_SPIN_CAP) { atomicAdd(&(bar)[XB_TMO], 1u); break; } } } } while (0)
struct XcdBarrier { unsigned* bar; unsigned x; volatile LAS unsigned* st; };
__device__ __forceinline__ XcdBarrier xcd_barrier_post(unsigned* bar, volatile LAS unsigned* st) {
    XcdBarrier b; b.bar = bar; b.x = xb_xcc_id(); b.st = st;
    if (threadIdx.x == 0) (void)xb_add(&bar[XB_XCNT(b.x)], 1u);
    return b;
}
__device__ __forceinline__ void xcd_barrier_complete(unsigned* bar, unsigned x, unsigned& nloc, unsigned& nx) {
    const unsigned G = gridDim.x * gridDim.y * gridDim.z;
    unsigned sum, cnt, mine, sp = 0u;
    for (;;) {
        sum = 0u; cnt = 0u; mine = 0u;
#pragma unroll
        for (unsigned j = 0; j < 16; ++j) { const unsigned c = xb_ld(&bar[XB_XCNT(j)]); sum += c; cnt += (c > 0u) ? 1u : 0u; mine = (j == x) ? c : mine; }
        if (sum == G) break;
        __builtin_amdgcn_s_sleep(1);
        if ((++sp & 255u) == 0u) { if (xb_ld(&bar[XB_TMO])) break; if (sp > XB_SPIN_CAP) { atomicAdd(&bar[XB_TMO], 1u); break; } }
    }
    nloc = mine > 0u ? mine : 1u; nx = cnt > 0u ? cnt : 1u;
}
__device__ __forceinline__ void xcd_barrier(const XcdBarrier& b) {
    asm volatile("s_waitcnt vmcnt(0)" ::: "memory");
    __syncthreads();
    if (threadIdx.x == 0) {
        unsigned* bar = b.bar;
        __builtin_amdgcn_s_waitcnt(0);
        unsigned nloc = b.st[0], nx = b.st[1];
        if (nloc == 0u) { xcd_barrier_complete(bar, b.x, nloc, nx); b.st[0] = nloc; b.st[1] = nx; }
        const unsigned old = xb_add(&bar[XB_XSUB(b.x)], 1u);
        const unsigned gen = old / nloc;
        if (old + 1u == (gen + 1u) * nloc) {
            __builtin_amdgcn_fence(__ATOMIC_RELEASE, "agent");
            asm volatile("s_waitcnt vmcnt(0)" ::: "memory");
            const unsigned og = xb_add(&bar[XB_TOP], 1u);
            const unsigned tg = og / nx;
            if (og + 1u == (tg + 1u) * nx) xb_add(&bar[XB_TOPGEN], 1u);
            else XB_SPIN(xb_ld(&bar[XB_TOPGEN]) == tg, bar);
            __builtin_amdgcn_fence(__ATOMIC_ACQUIRE, "agent");
            xb_add(&bar[XB_XGEN(b.x)], 1u);
            asm volatile("s_waitcnt vmcnt(0)" ::: "memory");
        } else {
            XB_SPIN(xb_ld(&bar[XB_XGEN(b.x)]) == gen, bar);
            __builtin_amdgcn_fence(__ATOMIC_ACQUIRE, "agent");
            asm volatile("s_waitcnt vmcnt(0)" ::: "memory");
        }
    }
    __syncthreads();
}

struct Params { const float* in[15]; float* out; unsigned char* ws; int ph_lo, ph_hi; };

__global__ void __launch_bounds__(512, 2) mega_fwd(Params P) {
    extern __shared__ __attribute__((aligned(16))) unsigned char lds_raw[];
    LAS unsigned char* lds = (LAS unsigned char*)lds_raw;
    cg::grid_group grid = cg::this_grid();
    volatile LAS unsigned* MISC = (volatile LAS unsigned*)(lds + 131072);
    if (threadIdx.x < 64) MISC[threadIdx.x] = 0u;
    __syncthreads();
    XcdBarrier xbar = xcd_barrier_post((unsigned*)((GAS unsigned char*)P.ws), MISC + 8);
    for (int ph = P.ph_lo; ph < P.ph_hi; ++ph) {
        int tid = threadIdx.x; asm volatile("" : "+v"(tid));
        size_t zoff = 0; asm volatile("" : "+s"(zoff));
        unsigned char* ws = (unsigned char*)((GAS unsigned char*)P.ws + zoff);
        float* outp = (float*)((GAS float*)P.out + zoff);
#define INP(i) ((const float*)((const GAS float*)P.in[i] + zoff))
        int G = gridDim.x, wg = blockIdx.x; asm volatile("" : "+s"(G), "+s"(wg));
        const int lane = tid & 63, wave = __builtin_amdgcn_readfirstlane(tid >> 6);
        const int gw = wg * 8 + wave, NGW = G * 8;
        const int gt = wg * 512 + tid, NGT = G * 512;
        bf16_t* XB = (bf16_t*)(ws + WS_XB);
        const int l = ph / NPH_LAYER, k = ph % NPH_LAYER;
        const float* xres = (l == 0) ? INP(0) : outp;
#ifdef ONLY
        if (k != ONLY) continue;
#endif
#ifdef SKIPK
        if (k == SKIPK) continue;
#endif
#ifdef SKIPK2
        if (k == SKIPK2) continue;
#endif
        switch (k) {
        case 0: {
            LAS float* scr = (LAS float*)(lds + wave * 16384);
            const int I0 = 16 * 264, I1 = 8 * 32, I2 = 8 * 32, I3 = 4 * 32, I4 = 16 * 32, I5 = 16 * 176, I6 = 44 * 32;
            const int NIT = I0 + I1 + I2 + I3 + I4 + I5 + I6;
            for (int it = gw; it < NIT; it += NGW) {
                int r = it;
                if (r < I0) { transpose_item(INP(1) + (size_t)l * DM * INC, DM, INC, (bf16_t*)(ws + W_IN), scr, r, lane); continue; } r -= I0;
                if (r < I1) { transpose_item(INP(3) + (size_t)l * 512 * DM, 512, DM, (bf16_t*)(ws + W_MOBA), scr, r, lane); continue; } r -= I1;
                if (r < I2) { transpose_item(INP(5) + (size_t)l * 512 * DM, 512, DM, (bf16_t*)(ws + W_CONV), scr, r, lane); continue; } r -= I2;
                if (r < I3) { transpose_item(INP(4) + (size_t)l * 256 * DM, 256, DM, (bf16_t*)(ws + W_DIL), scr, r, lane); continue; } r -= I3;
                if (r < I4) { transpose_item(INP(6) + (size_t)l * DM * DM, DM, DM, (bf16_t*)(ws + W_MIX), scr, r, lane); continue; } r -= I4;
                if (r < I5) { transpose_item(INP(9) + (size_t)l * DM * DFF2, DM, DFF2, (bf16_t*)(ws + W_UP), scr, r, lane); continue; } r -= I5;
                transpose_item(INP(12) + (size_t)l * DFF * DM, DFF, DM, (bf16_t*)(ws + W_DOWN), scr, r, lane);
            }
            if (l == 0) {
                const float* x = INP(0);
                for (int it = gt; it < M_TOK * DM / 8; it += NGT) {
                    const f32x4 a = *(const f32x4*)(x + (size_t)it * 8), c = *(const f32x4*)(x + (size_t)it * 8 + 4);
                    u32x4 o; o.x = cvtpk(a[0], a[1]); o.y = cvtpk(a[2], a[3]); o.z = cvtpk(c[0], c[1]); o.w = cvtpk(c[2], c[3]);
                    *(u32x4*)(XB + (size_t)it * 8) = o;
                }
            }
        } break;
        case 1: {
            pg8::SchedIN S{G, wg, (const char*)XB, (const char*)(ws + W_IN), ws};
            pg8::EpiBf16<0> E;
            pg8::gemm_phase(lds, tid, DM, 2048u, S, E);
        } break;
        case 2: {
            {
                LAS float* red = (LAS float*)lds;
                const bf16_t* KA = (const bf16_t*)(ws + B_KA);
                for (int it = wg; it < 256; it += G) {
                    const int b = it >> 7, j = (it >> 2) & 31, cgp = it & 3;
                    const int col = cgp * 128 + (tid & 127), rp = tid >> 7;
                    const bf16_t* src = KA + (size_t)(b * SEQ + j * 256 + rp * 64) * 512 + col;
                    float s = 0.f;
                    for (int rr = 0; rr < 64; ++rr) s += __uint_as_float((unsigned)src[(size_t)rr * 512] << 16);
                    __syncthreads();
                    red[tid] = s;
                    __syncthreads();
                    if (tid < 128) {
                        const float tot = (red[tid] + red[tid + 128]) + (red[tid + 256] + red[tid + 384]);
                        const int hh = col >> 6, d = col & 63;
                        ((float*)(ws + WS_KMEAN))[(size_t)((b * 8 + hh) * 32 + j) * 64 + d] = tot * (1.0f / 256.0f);
                    }
                }
            }
            {
                bf16_t* BC = (bf16_t*)(ws + B_BC); const bf16_t* CCp = (const bf16_t*)(ws + B_CC); const bf16_t* HHp = (const bf16_t*)(ws + B_HH);
                const float* wsc = INP(2) + (size_t)l * 3 * 512;
                for (int it = gt; it < M_TOK * 64; it += NGT) {
                    const int row = it >> 6, c8 = (it & 63) * 8, tpos = row & (SEQ - 1);
                    float accv[8];
#pragma unroll
                    for (int e = 0; e < 8; ++e) accv[e] = 0.f;
#pragma unroll
                    for (int j = 0; j < 3; ++j) {
                        if (tpos >= j) {
                            const u32x4 cv = *(const u32x4*)(CCp + (size_t)(row - j) * 512 + c8), hv = *(const u32x4*)(HHp + (size_t)(row - j) * 512 + c8);
                            const f32x4 w0 = *(const f32x4*)(wsc + j * 512 + c8), w1 = *(const f32x4*)(wsc + j * 512 + c8 + 4);
                            accv[0] += w0[0] * bflo(cv.x) * bflo(hv.x); accv[1] += w0[1] * bfhi(cv.x) * bfhi(hv.x);
                            accv[2] += w0[2] * bflo(cv.y) * bflo(hv.y); accv[3] += w0[3] * bfhi(cv.y) * bfhi(hv.y);
                            accv[4] += w1[0] * bflo(cv.z) * bflo(hv.z); accv[5] += w1[1] * bfhi(cv.z) * bfhi(hv.z);
                            accv[6] += w1[2] * bflo(cv.w) * bflo(hv.w); accv[7] += w1[3] * bfhi(cv.w) * bfhi(hv.w);
                        }
                    }
                    const u32x4 bv = *(const u32x4*)(BC + (size_t)row * 512 + c8);
                    u32x4 o;
                    o.x = cvtpk(bflo(bv.x) * accv[0], bfhi(bv.x) * accv[1]); o.y = cvtpk(bflo(bv.y) * accv[2], bfhi(bv.y) * accv[3]);
                    o.z = cvtpk(bflo(bv.z) * accv[4], bfhi(bv.z) * accv[5]); o.w = cvtpk(bflo(bv.w) * accv[6], bfhi(bv.w) * accv[7]);
                    *(u32x4*)(BC + (size_t)row * 512 + c8) = o;
                }
            }
        } break;
        case 3: {
            const int vcu = (G % 8 == 0) ? (wg % 8) * (G / 8) + wg / 8 : wg;
            for (int uidx = vcu; uidx < 256; uidx += G) {
                const int bh = uidx >> 4, s = uidx & 15;
                moba_tile(ws, bh >> 3, bh & 7, s, wave, lane);
                moba_tile(ws, bh >> 3, bh & 7, 31 - s, wave, lane);
            }
            { const int per = (6144 + NGW - 1) / NGW, t0 = (vcu * 8 + wave) * per;
              for (int t = t0; t < t0 + per && t < 6144; ++t) dil_tile(ws, t, lane); }
        } break;
        case 4: {
            {
                const bf16_t* QD = (const bf16_t*)(ws + B_QD); const float* LSE = (const float*)(ws + WS_LSE); bf16_t* YD = (bf16_t*)(ws + B_YD);
                for (int it = gt; it < M_TOK * 32; it += NGT) {
                    const int row = it >> 5, hh = (it >> 3) & 3, d8 = (it & 7) * 8;
                    const float l0 = LSE[(size_t)row * 12 + hh], l1 = LSE[(size_t)row * 12 + 4 + hh], l2 = LSE[(size_t)row * 12 + 8 + hh];
                    const float mx = fmaxf(l0, fmaxf(l1, l2));
                    float e0 = __expf(l0 - mx), e1 = __expf(l1 - mx), e2 = __expf(l2 - mx);
                    const float inv = 1.0f / (e0 + e1 + e2); e0 *= inv; e1 *= inv; e2 *= inv;
                    const u32x4 a = *(const u32x4*)(QD + (size_t)row * 768 + hh * 64 + d8), bq = *(const u32x4*)(QD + (size_t)row * 768 + 256 + hh * 64 + d8),
                                c = *(const u32x4*)(QD + (size_t)row * 768 + 512 + hh * 64 + d8);
                    u32x4 o;
                    o.x = cvtpk(e0 * bflo(a.x) + e1 * bflo(bq.x) + e2 * bflo(c.x), e0 * bfhi(a.x) + e1 * bfhi(bq.x) + e2 * bfhi(c.x));
                    o.y = cvtpk(e0 * bflo(a.y) + e1 * bflo(bq.y) + e2 * bflo(c.y), e0 * bfhi(a.y) + e1 * bfhi(bq.y) + e2 * bfhi(c.y));
                    o.z = cvtpk(e0 * bflo(a.z) + e1 * bflo(bq.z) + e2 * bflo(c.z), e0 * bfhi(a.z) + e1 * bfhi(bq.z) + e2 * bfhi(c.z));
                    o.w = cvtpk(e0 * bflo(a.w) + e1 * bflo(bq.w) + e2 * bflo(c.w), e0 * bfhi(a.w) + e1 * bfhi(bq.w) + e2 * bfhi(c.w));
                    *(u32x4*)(YD + (size_t)row * 256 + hh * 64 + d8) = o;
                }
            }
            pg8::SchedSimple S{64, 12, G, wg, (const char*)XB, (size_t)256 * 2048, (const char*)(ws + W_IN) + (size_t)5376 * 2048, (size_t)256 * 2048, 2048u, (bf16_t*)(ws + B_G), 3072};
            pg8::EpiBf16<1> E;
            pg8::gemm_phase(lds, tid, DM, 2048u, S, E);
        } break;
        case 5: {
            bf16_t* MG = XB;
            { pg8::SchedSimple S{64, 4, G, wg, (const char*)(ws + B_QA), (size_t)256 * 1024, (const char*)(ws + W_MOBA), (size_t)256 * 1024, 1024u, MG, 1024};
              pg8::EpiMerge<true> E{(const bf16_t*)(ws + B_G), MG, 0}; pg8::gemm_phase(lds, tid, 512, 1024u, S, E); }
            { pg8::SchedSimple S{64, 4, G, wg, (const char*)(ws + B_BC), (size_t)256 * 1024, (const char*)(ws + W_CONV), (size_t)256 * 1024, 1024u, MG, 1024};
              pg8::EpiMerge<false> E{(const bf16_t*)(ws + B_G), MG, 1}; pg8::gemm_phase(lds, tid, 512, 1024u, S, E); }
            { pg8::SchedSimple S{64, 4, G, wg, (const char*)(ws + B_YD), (size_t)256 * 512, (const char*)(ws + W_DIL), (size_t)256 * 512, 512u, MG, 1024};
              pg8::EpiMerge<false> E{(const bf16_t*)(ws + B_G), MG, 2}; pg8::gemm_phase(lds, tid, 256, 512u, S, E); }
        } break;
        case 6: {
            pg8::SchedSimple S{64, 4, G, wg, (const char*)XB, (size_t)256 * 2048, (const char*)(ws + W_MIX), (size_t)256 * 2048, 2048u, nullptr, 0};
            pg8::EpiRes E{xres, outp};
            pg8::gemm_phase(lds, tid, DM, 2048u, S, E);
        } break;
        case 7: case 13: {
            const float* gam = INP(k == 7 ? 7 : 13) + (size_t)l * DM; const float* bet = INP(k == 7 ? 8 : 14) + (size_t)l * DM;
            for (int m = gw; m < M_TOK; m += NGW) {
                f32x4* xr = (f32x4*)(outp + (size_t)m * DM) + lane;
                f32x4 v[4]; float s = 0.f;
#pragma unroll
                for (int j = 0; j < 4; ++j) { v[j] = xr[64 * j]; s += (v[j][0] + v[j][1]) + (v[j][2] + v[j][3]); }
                const float mean = wave_sum(s) * (1.f / DM); float s2 = 0.f;
#pragma unroll
                for (int j = 0; j < 4; ++j) { v[j] = v[j] - mean; s2 += (v[j][0] * v[j][0] + v[j][1] * v[j][1]) + (v[j][2] * v[j][2] + v[j][3] * v[j][3]); }
                const float rstd = 1.f / sqrtf(wave_sum(s2) * (1.f / DM) + LN_EPS);
                u32x2* o8 = (u32x2*)(XB + (size_t)m * DM) + lane;
#pragma unroll
                for (int j = 0; j < 4; ++j) {
                    const f32x4 gg = *((const f32x4*)gam + lane + 64 * j), bb = *((const f32x4*)bet + lane + 64 * j);
                    const f32x4 y = v[j] * rstd * gg + bb;
                    xr[64 * j] = y;
                    u32x2 o; o.x = cvtpk(y[0], y[1]); o.y = cvtpk(y[2], y[3]); o8[64 * j] = o;
                }
            }
        } break;
        case 8: case 10: {
            const int bb = (k == 10);
            pg8::SchedSimple S{32, 22, G, wg, (const char*)XB + (size_t)bb * SEQ * 2048, (size_t)256 * 2048, (const char*)(ws + W_UP), (size_t)256 * 2048, 2048u, (bf16_t*)(ws + B_U), DFF2};
            pg8::EpiBf16<0> E;
            pg8::gemm_phase(lds, tid, DM, 2048u, S, E);
        } break;
        case 9: case 11: {
            const int bb = (k == 11);
            const bf16_t* U = (const bf16_t*)(ws + B_U); bf16_t* Hh = (bf16_t*)(ws + B_H) + (size_t)bb * SEQ * DFF;
            const float* wf = INP(10) + (size_t)l * 3 * DFF2; const float* bfc = INP(11) + (size_t)l * DFF2;
            for (int it = gt; it < SEQ * 352; it += NGT) {
                const int t = it / 352, c8 = (it % 352) * 8;
                float ga[8], va[8];
                { const f32x4 b0 = *(const f32x4*)(bfc + c8), b1 = *(const f32x4*)(bfc + c8 + 4), d0 = *(const f32x4*)(bfc + DFF + c8), d1 = *(const f32x4*)(bfc + DFF + c8 + 4);
#pragma unroll
                  for (int e = 0; e < 4; ++e) { ga[e] = b0[e]; ga[4 + e] = b1[e]; va[e] = d0[e]; va[4 + e] = d1[e]; } }
#pragma unroll
                for (int j = 0; j < 3; ++j) {
                    if (t >= j) {
                        const u32x4 ug = *(const u32x4*)(U + (size_t)(t - j) * DFF2 + c8), uv = *(const u32x4*)(U + (size_t)(t - j) * DFF2 + DFF + c8);
                        const f32x4 w0 = *(const f32x4*)(wf + j * DFF2 + c8), w1 = *(const f32x4*)(wf + j * DFF2 + c8 + 4);
                        const f32x4 x0 = *(const f32x4*)(wf + j * DFF2 + DFF + c8), x1 = *(const f32x4*)(wf + j * DFF2 + DFF + c8 + 4);
                        ga[0] += w0[0] * bflo(ug.x); ga[1] += w0[1] * bfhi(ug.x); ga[2] += w0[2] * bflo(ug.y); ga[3] += w0[3] * bfhi(ug.y);
                        ga[4] += w1[0] * bflo(ug.z); ga[5] += w1[1] * bfhi(ug.z); ga[6] += w1[2] * bflo(ug.w); ga[7] += w1[3] * bfhi(ug.w);
                        va[0] += x0[0] * bflo(uv.x); va[1] += x0[1] * bfhi(uv.x); va[2] += x0[2] * bflo(uv.y); va[3] += x0[3] * bfhi(uv.y);
                        va[4] += x1[0] * bflo(uv.z); va[5] += x1[1] * bfhi(uv.z); va[6] += x1[2] * bflo(uv.w); va[7] += x1[3] * bfhi(uv.w);
                    }
                }
                float hv[8];
#pragma unroll
                for (int e = 0; e < 8; ++e) hv[e] = ga[e] * fast_sigmoid(ga[e]) * va[e];
                u32x4 o; o.x = cvtpk(hv[0], hv[1]); o.y = cvtpk(hv[2], hv[3]); o.z = cvtpk(hv[4], hv[5]); o.w = cvtpk(hv[6], hv[7]);
                *(u32x4*)(Hh + (size_t)t * DFF + c8) = o;
            }
        } break;
        case 12: {
            pg8::SchedSimple S{64, 4, G, wg, (const char*)(ws + B_H), (size_t)256 * DFF * 2, (const char*)(ws + W_DOWN), (size_t)256 * DFF * 2, (unsigned)(DFF * 2), nullptr, 0};
            pg8::EpiRes E{outp, outp};
            pg8::gemm_phase(lds, tid, DFF, (unsigned)(DFF * 2), S, E);
        } break;
        default: break;
        }
        if (ph + 1 < P.ph_hi) {
            if (ph == P.ph_lo) grid.sync();
            else xcd_barrier(xbar);
#ifdef PROBE_SYNC
            for (int rep = 0; rep < PROBE_SYNC; ++rep) xcd_barrier(xbar);
#endif
        }
    }
}

constexpr int LDS_BYTES = 131072 + 1024;

extern "C" void kernel_launch(void* const* d_in, const int* in_sizes, int n_in, void* d_out, int out_size, void* d_ws, size_t ws_size, hipStream_t stream) {
    static int grid = 0;
    if (grid == 0) {
        if (n_in != 15 || out_size != M_TOK * DM || ws_size < WS_NEED) { fprintf(stderr, "kernel_launch: unexpected shapes (n_in %d out %d ws %zu need %zu)\n", n_in, out_size, ws_size, (size_t)WS_NEED); grid = -1; return; }
        int dev = 0, cus = 0, per_cu = 0;
        hipGetDevice(&dev);
        hipDeviceGetAttribute(&cus, hipDeviceAttributeMultiprocessorCount, dev);
        hipFuncSetAttribute((const void*)mega_fwd, hipFuncAttributeMaxDynamicSharedMemorySize, LDS_BYTES);
        hipOccupancyMaxActiveBlocksPerMultiprocessor(&per_cu, (const void*)mega_fwd, 512, LDS_BYTES);
        if (per_cu < 1) { fprintf(stderr, "kernel_launch: occupancy query says %d blocks/CU\n", per_cu); per_cu = 1; }
        grid = cus;
        (void)hipGetLastError();
    }
    if (grid < 0) return;
    if (hipMemsetAsync(d_ws, 0, 16384, stream) != hipSuccess) { fprintf(stderr, "kernel_launch: memset failed\n"); return; }
    Params p{};
    for (int i = 0; i < 15; ++i) p.in[i] = (const float*)d_in[i];
    p.out = (float*)d_out; p.ws = (unsigned char*)d_ws;
#ifndef MK_SPLIT
    p.ph_lo = 0; p.ph_hi = NPH;
    void* args[] = {&p};
    hipError_t e = hipLaunchCooperativeKernel((const void*)mega_fwd, dim3(grid), dim3(512), args, LDS_BYTES, stream);
    if (e != hipSuccess) fprintf(stderr, "cooperative launch failed: %s (grid %d)\n", hipGetErrorString(e), grid);
#else
    for (int ph = 0; ph < NPH; ++ph) {
        p.ph_lo = ph; p.ph_hi = ph + 1;
        void* args[] = {&p};
        hipError_t e = hipLaunchCooperativeKernel((const void*)mega_fwd, dim3(grid), dim3(512), args, LDS_BYTES, stream);
        if (e != hipSuccess) { fprintf(stderr, "launch %d failed: %s\n", ph, hipGetErrorString(e)); break; }
    }
#endif
}
```

```cpp
#include <hip/hip_runtime.h>
#include <hip/hip_cooperative_groups.h>
#include <cstdio>
#include <cstdint>
namespace cg = cooperative_groups;

#define LAS __attribute__((address_space(3)))
#define GAS __attribute__((address_space(1)))
typedef unsigned short bf16_t;
typedef short bf16x8 __attribute__((ext_vector_type(8)));
typedef short s16x4 __attribute__((ext_vector_type(4)));
typedef float f32x4 __attribute__((ext_vector_type(4)));
typedef float f32x16 __attribute__((ext_vector_type(16)));
typedef unsigned u32x4 __attribute__((ext_vector_type(4)));
typedef unsigned u32x2 __attribute__((ext_vector_type(2)));
typedef float f32x2_t __attribute__((ext_vector_type(2)));
typedef __bf16 bf16x2_t __attribute__((ext_vector_type(2)));

constexpr int M_TOK = 16384, SEQ = 8192, DM = 1024, INC = 8448, DFF = 2816, DFF2 = 5632;
constexpr float LN_EPS = 1e-5f;
constexpr float DN_ALPHA = 1.41421356237f;
constexpr int NPH_LAYER = 14, NPH = 2 * NPH_LAYER;

constexpr size_t MiB = 1u << 20;
constexpr size_t W_IN = 1 * MiB;
constexpr size_t W_MOBA = W_IN + (size_t)INC * DM * 2;
constexpr size_t W_CONV = W_MOBA + 1024 * 512 * 2;
constexpr size_t W_DIL = W_CONV + 1024 * 512 * 2;
constexpr size_t W_MIX = W_DIL + 1024 * 256 * 2;
constexpr size_t W_UP = W_MIX + 1024 * 1024 * 2;
constexpr size_t W_DOWN = W_UP + (size_t)DFF2 * DM * 2;
constexpr size_t W_END = W_DOWN + (size_t)DM * DFF * 2;
constexpr size_t WS_XB = W_END;
constexpr size_t WS_KMEAN = WS_XB + 32 * MiB;
constexpr size_t WS_LSE = WS_KMEAN + 131072;
constexpr size_t WS_BIG = WS_KMEAN + 1 * MiB;
constexpr size_t B_QA = WS_BIG, B_BC = B_QA + 16 * MiB, B_QD = B_BC + 16 * MiB, B_YD = B_QD + 24 * MiB, B_KA = B_YD + 8 * MiB,
                 B_VTA = B_KA + 16 * MiB, B_KD = B_VTA + 16 * MiB, B_VTD = B_KD + 24 * MiB, B_CC = B_VTD + 24 * MiB, B_HH = B_CC + 16 * MiB,
                 B_END = B_HH + 16 * MiB;
constexpr size_t B_G = B_KA;
constexpr size_t B_U = WS_BIG;
constexpr size_t B_H = WS_BIG + 88 * MiB;
constexpr size_t WS_NEED = B_END;
static_assert(W_END % 256 == 0 && B_G + 96 * MiB <= B_HH && B_H + 88 * MiB <= B_END, "ws map");

__device__ __forceinline__ unsigned cvtpk(float lo, float hi) { f32x2_t v = {lo, hi}; bf16x2_t b = __builtin_convertvector(v, bf16x2_t); return __builtin_bit_cast(unsigned, b); }
__device__ __forceinline__ float bflo(unsigned w) { return __uint_as_float(w << 16); }
__device__ __forceinline__ float bfhi(unsigned w) { return __uint_as_float(w & 0xffff0000u); }
__device__ __forceinline__ float fast_sigmoid(float x) { return __builtin_amdgcn_rcpf(1.0f + __builtin_amdgcn_exp2f(-1.44269504089f * x)); }

namespace pg8 {
constexpr int BM = 256, BK = 64, HALF = 128, HTB = HALF * BK * 2, STAGE_BYTES = 8 * HTB, NXCD = 8, WGM = 8;
__host__ __device__ __forceinline__ int lds_byte(int r, int c) { const int st = (r >> 4) * 2 + (c >> 5), rr = r & 15, cc = c & 31, ob = rr * 64 + cc * 2; return st * 1024 + (ob ^ (((ob >> 9) & 1) << 5)); }
__host__ __device__ __forceinline__ void stage_rc(int b, int& R, int& C) { const int st = b / 1024, sb = b % 1024, swz = sb ^ (((sb >> 9) & 1) << 5); R = (st >> 1) * 16 + swz / 64; C = (st & 1) * 32 + (swz % 64) / 2; }
__host__ __device__ __forceinline__ int perm32(int rho) { const int n = rho >> 4, i = rho & 15; return 8 * (i >> 2) + 4 * n + (i & 3); }

struct GUnit { const char* A; const char* B; unsigned ldb; bf16_t* O; int ldc; int r0, c0; };

__device__ __forceinline__ void tile_order(int wgid, int nM, int nN, int& pm, int& pn) {
    const int nwg = nM * nN;
    { const int q = nwg / NXCD, r = nwg % NXCD, xcd = wgid % NXCD, off = wgid / NXCD; wgid = (xcd < r ? xcd * (q + 1) : r * (q + 1) + (xcd - r) * q) + off; }
    const int nig = WGM * nN, gid = wgid / nig, fm = gid * WGM, gsz = (nM - fm) < WGM ? (nM - fm) : WGM;
    pm = fm + ((wgid % nig) % gsz); pn = (wgid % nig) / gsz;
}

template <class Sched, class Epi>
__device__ __forceinline__ void gemm_phase(LAS unsigned char* lds, const int tid, const int K, const unsigned lda, const Sched& S, const Epi& E) {
    const int wid = __builtin_amdgcn_readfirstlane(tid >> 6), lane = tid & 63, wr = wid >> 2, wc = wid & 3, fr = lane & 15, fq = lane >> 4;
    const int nt = K / BK;
    unsigned voffA[2], RB[2], CC2[2];
#pragma unroll
    for (int i = 0; i < 2; ++i) { int R, C; stage_rc(tid * 16 + i * 8192, R, C); const int Rb = (R & ~31) + perm32(R & 31);
        voffA[i] = (unsigned)R * lda + (unsigned)C * 2u; RB[i] = (unsigned)Rb; CC2[i] = (unsigned)C * 2u; }
    const size_t kstep = (size_t)(BK * 2);
    const size_t hstepA = (size_t)HALF * lda;
    const unsigned ldsw = (unsigned)wid * 1024u;
    const int aoff = lds_byte(wr * 64 + fr, fq * 8), boff = lds_byte(wc * 32 + fr, fq * 8);
#define PG8_SA(b, h) (((b) * 2 + (h)) * HTB)
#define PG8_SB(b, h) ((4 + (b) * 2 + (h)) * HTB)
#define PG8_STAGE(bufoff, gbase, voff) do { _Pragma("unroll") for (int _i = 0; _i < 2; ++_i) \
        __builtin_amdgcn_global_load_lds((const unsigned*)((const char*)(gbase) + (voff)[_i]), (LAS unsigned*)(lds + (bufoff) + ldsw + _i * 8192), 16, 0, 0); } while (0)
#define PG8_LDA(dst, b, h) do { _Pragma("unroll") for (int m = 0; m < 4; ++m) _Pragma("unroll") for (int k = 0; k < 2; ++k) dst[m][k] = *(const LAS bf16x8*)(lds + PG8_SA(b, h) + aoff + m * 2048 + k * 1024); } while (0)
#define PG8_LDB(dst, b, h) do { _Pragma("unroll") for (int n = 0; n < 2; ++n) _Pragma("unroll") for (int k = 0; k < 2; ++k) dst[n][k] = *(const LAS bf16x8*)(lds + PG8_SB(b, h) + boff + n * 2048 + k * 1024); } while (0)
#define PG8_MMA(ai, bj, At, Bt) do { __builtin_amdgcn_s_setprio(1); _Pragma("unroll") for (int m = 0; m < 4; ++m) _Pragma("unroll") for (int n = 0; n < 2; ++n) _Pragma("unroll") for (int k = 0; k < 2; ++k) \
        acc[ai][bj][m][n] = __builtin_amdgcn_mfma_f32_16x16x32_bf16(Bt[n][k], At[m][k], acc[ai][bj][m][n], 0, 0, 0); __builtin_amdgcn_s_setprio(0); } while (0)
#define PG8_WAIT_V(n) asm volatile("s_waitcnt vmcnt(" #n ")" ::: "memory")
#define PG8_WAIT_L(n) asm volatile("s_waitcnt lgkmcnt(" #n ")" ::: "memory")
#define PG8_BAR __builtin_amdgcn_s_barrier()
#define PG8_SCHED __builtin_amdgcn_sched_barrier(0)
    GUnit cur, nxt; int ui = 0;
    if (!S.next(0, cur)) return;
    f32x4 acc[2][2][4][2];
#pragma unroll
    for (int a = 0; a < 2; ++a)
#pragma unroll
        for (int b = 0; b < 2; ++b)
#pragma unroll
            for (int m = 0; m < 4; ++m)
#pragma unroll
                for (int n = 0; n < 2; ++n) acc[a][b][m][n] = (f32x4){0.f, 0.f, 0.f, 0.f};
    bf16x8 At[4][2], B0[2][2], B1[2][2];
    const char* cA = cur.A; const char* cB = cur.B;
    unsigned vBc[2] = {RB[0] * cur.ldb + CC2[0], RB[1] * cur.ldb + CC2[1]};
    size_t hBc = (size_t)HALF * cur.ldb;
    PG8_STAGE(PG8_SB(0, 0), cB, vBc); PG8_STAGE(PG8_SB(0, 1), cB + hBc, vBc); PG8_STAGE(PG8_SA(0, 0), cA, voffA); PG8_STAGE(PG8_SA(0, 1), cA + hstepA, voffA);
    if (wr == 1) PG8_BAR;
    PG8_WAIT_V(2); PG8_BAR;
    PG8_STAGE(PG8_SB(1, 0), cB + kstep, vBc); PG8_STAGE(PG8_SA(1, 0), cA + kstep, voffA); PG8_STAGE(PG8_SB(1, 1), cB + hBc + kstep, vBc);
    PG8_WAIT_V(6); PG8_BAR;
    for (;;) {
        const bool has_next = S.next(ui + 1, nxt);
        const char* nA = has_next ? nxt.A : cA; const char* nB = has_next ? nxt.B : cB;
        const unsigned nldb = has_next ? nxt.ldb : cur.ldb;
        unsigned vBn[2] = {RB[0] * nldb + CC2[0], RB[1] * nldb + CC2[1]};
        const size_t hBn = (size_t)HALF * nldb;
        for (int t = 0; t < nt; t += 2) {
            const bool last = (t == nt - 2);
            const char* a1 = cA + (size_t)(t + 1) * kstep;
            const char* a2 = last ? nA : cA + (size_t)(t + 2) * kstep; const char* b2 = last ? nB : cB + (size_t)(t + 2) * kstep;
            const char* a3 = a2 + kstep; const char* b3 = b2 + kstep;
            unsigned vB[2] = {last ? vBn[0] : vBc[0], last ? vBn[1] : vBc[1]};
            const size_t hB = last ? hBn : hBc;
            PG8_LDB(B0, 0, 0); PG8_LDB(B1, 0, 1); PG8_SCHED; PG8_LDA(At, 0, 0); PG8_STAGE(PG8_SA(1, 1), a1 + hstepA, voffA);
            PG8_WAIT_V(8); PG8_WAIT_L(0); PG8_BAR; PG8_MMA(0, 0, At, B0); PG8_MMA(0, 1, At, B1); PG8_BAR; PG8_SCHED;
            PG8_LDA(At, 0, 1); PG8_STAGE(PG8_SB(0, 0), b2, vB); PG8_STAGE(PG8_SB(0, 1), b2 + hB, vB); PG8_STAGE(PG8_SA(0, 0), a2, voffA);
            PG8_WAIT_V(8); PG8_WAIT_L(0); PG8_BAR; PG8_MMA(1, 0, At, B0); PG8_MMA(1, 1, At, B1); PG8_BAR; PG8_SCHED;
            PG8_LDB(B0, 1, 0); PG8_LDB(B1, 1, 1); PG8_SCHED; PG8_LDA(At, 1, 0); PG8_STAGE(PG8_SA(0, 1), a2 + hstepA, voffA);
            PG8_WAIT_V(8); PG8_WAIT_L(0); PG8_BAR; PG8_MMA(0, 0, At, B0); PG8_MMA(0, 1, At, B1); PG8_BAR; PG8_SCHED;
            PG8_LDA(At, 1, 1); PG8_STAGE(PG8_SB(1, 0), b3, vB); PG8_STAGE(PG8_SB(1, 1), b3 + hB, vB); PG8_STAGE(PG8_SA(1, 0), a3, voffA);
            PG8_WAIT_V(8); PG8_WAIT_L(0); PG8_BAR; PG8_MMA(1, 0, At, B0); PG8_MMA(1, 1, At, B1); PG8_BAR; PG8_SCHED;
        }
        if (wr == 0) PG8_BAR;
        E(acc, cur, wr, wc, fr, fq);
        if (!has_next) break;
#pragma unroll
        for (int a = 0; a < 2; ++a)
#pragma unroll
            for (int b = 0; b < 2; ++b)
#pragma unroll
                for (int m = 0; m < 4; ++m)
#pragma unroll
                    for (int n = 0; n < 2; ++n) acc[a][b][m][n] = (f32x4){0.f, 0.f, 0.f, 0.f};
        cur = nxt; cA = nA; cB = nB; vBc[0] = vBn[0]; vBc[1] = vBn[1]; hBc = hBn; ++ui;
        if (wr == 1) PG8_BAR;
    }
    PG8_WAIT_V(0);
    PG8_BAR;
#undef PG8_SA
#undef PG8_SB
#undef PG8_STAGE
#undef PG8_LDA
#undef PG8_LDB
#undef PG8_MMA
#undef PG8_WAIT_V
#undef PG8_WAIT_L
#undef PG8_BAR
#undef PG8_SCHED
}

template <int ACT> struct EpiBf16 {
    __device__ __forceinline__ void operator()(const f32x4 (&acc)[2][2][4][2], const GUnit& u, int wr, int wc, int fr, int fq) const {
#pragma unroll
        for (int ai = 0; ai < 2; ++ai)
#pragma unroll
            for (int m = 0; m < 4; ++m) {
                const int row = u.r0 + ai * HALF + wr * 64 + m * 16 + fr;
                bf16_t* rowp = u.O + (size_t)row * u.ldc + u.c0 + wc * 32 + 8 * fq;
#pragma unroll
                for (int bj = 0; bj < 2; ++bj) {
                    f32x4 v0 = acc[ai][bj][m][0], v1 = acc[ai][bj][m][1];
                    if (ACT == 1) {
#pragma unroll
                        for (int k = 0; k < 4; ++k) { v0[k] = fast_sigmoid(v0[k]); v1[k] = fast_sigmoid(v1[k]); }
                    }
                    u32x4 w; w.x = cvtpk(v0[0], v0[1]); w.y = cvtpk(v0[2], v0[3]); w.z = cvtpk(v1[0], v1[1]); w.w = cvtpk(v1[2], v1[3]);
                    *(u32x4*)(rowp + bj * HALF) = w;
                }
            }
    }
};
template <bool FIRST> struct EpiMerge {
    const bf16_t* G; bf16_t* Mg; int gi;
    __device__ __forceinline__ void operator()(const f32x4 (&acc)[2][2][4][2], const GUnit& u, int wr, int wc, int fr, int fq) const {
#pragma unroll
        for (int ai = 0; ai < 2; ++ai)
#pragma unroll
            for (int m = 0; m < 4; ++m) {
                const int row = u.r0 + ai * HALF + wr * 64 + m * 16 + fr;
#pragma unroll
                for (int bj = 0; bj < 2; ++bj) {
                    const int col = u.c0 + bj * HALF + wc * 32 + 8 * fq;
                    const u32x4 g = *(const u32x4*)(G + (size_t)row * 3072 + gi * 1024 + col);
                    bf16_t* mp = Mg + (size_t)row * 1024 + col;
                    u32x4 o = (u32x4){0u, 0u, 0u, 0u};
                    if (!FIRST) o = *(const u32x4*)mp;
                    const f32x4 v0 = acc[ai][bj][m][0], v1 = acc[ai][bj][m][1];
                    u32x4 w;
                    w.x = cvtpk(bflo(g.x) * v0[0] + bflo(o.x), bfhi(g.x) * v0[1] + bfhi(o.x));
                    w.y = cvtpk(bflo(g.y) * v0[2] + bflo(o.y), bfhi(g.y) * v0[3] + bfhi(o.y));
                    w.z = cvtpk(bflo(g.z) * v1[0] + bflo(o.z), bfhi(g.z) * v1[1] + bfhi(o.z));
                    w.w = cvtpk(bflo(g.w) * v1[2] + bflo(o.w), bfhi(g.w) * v1[3] + bfhi(o.w));
                    *(u32x4*)mp = w;
                }
            }
    }
};
struct EpiRes {
    const float* base; float* out;
    __device__ __forceinline__ void operator()(const f32x4 (&acc)[2][2][4][2], const GUnit& u, int wr, int wc, int fr, int fq) const {
#pragma unroll
        for (int ai = 0; ai < 2; ++ai)
#pragma unroll
            for (int m = 0; m < 4; ++m) {
                const int row = u.r0 + ai * HALF + wr * 64 + m * 16 + fr;
#pragma unroll
                for (int bj = 0; bj < 2; ++bj) {
                    const size_t off = (size_t)row * 1024 + u.c0 + bj * HALF + wc * 32 + 8 * fq;
                    const f32x4 b0 = *(const f32x4*)(base + off), b1 = *(const f32x4*)(base + off + 4);
                    *(f32x4*)(out + off) = b0 * DN_ALPHA + acc[ai][bj][m][0];
                    *(f32x4*)(out + off + 4) = b1 * DN_ALPHA + acc[ai][bj][m][1];
                }
            }
    }
};

struct SchedSimple {
    int nM, nN, G, c; const char* A; size_t a_tile; const char* B; size_t b_tile; unsigned ldb; bf16_t* O; int ldc;
    __device__ __forceinline__ bool next(int i, GUnit& u) const {
        const long L = (long)i * G + c; if (L >= (long)nM * nN) return false;
        int pm, pn; tile_order((int)L, nM, nN, pm, pn);
        u.A = A + (size_t)pm * a_tile; u.B = B + (size_t)pn * b_tile; u.ldb = ldb; u.O = O; u.ldc = ldc; u.r0 = pm * 256; u.c0 = pn * 256; return true;
    }
};
struct SchedIN {
    int G, c; const char* xb; const char* wt; unsigned char* ws;
    __device__ __forceinline__ bool next(int i, GUnit& u) const {
        const long L = (long)i * G + c; if (L >= 1344) return false;
        if (L < 1024) {
            int pm, pn; tile_order((int)L, 64, 16, pm, pn);
            const int wtile = pn < 4 ? pn : (pn < 10 ? pn + 2 : pn + 5);
            u.A = xb + (size_t)pm * 256 * 2048; u.B = wt + (size_t)wtile * 256 * 2048; u.ldb = 2048; u.r0 = pm * 256;
            size_t sec; int ct, ldc = 512;
            if (wtile < 2) { sec = B_QA; ct = wtile; }
            else if (wtile < 4) { sec = B_KA; ct = wtile - 2; }
            else if (wtile < 9) { sec = B_QD; ct = wtile - 6; ldc = 768; }
            else if (wtile < 12) { sec = B_KD; ct = wtile - 9; ldc = 768; }
            else if (wtile < 17) { sec = B_BC; ct = wtile - 15; }
            else if (wtile < 19) { sec = B_CC; ct = wtile - 17; }
            else { sec = B_HH; ct = wtile - 19; }
            u.O = (bf16_t*)(ws + sec); u.ldc = ldc; u.c0 = ct * 256;
        } else {
            const int v = (int)L - 1024, sub = v >> 6, it = v & 63;
            u.ldc = 16384; u.c0 = it * 256;
            if (sub < 2) {
                u.A = wt + (size_t)(1024 + 256 * sub) * 2048; u.B = xb + (size_t)it * 256 * 2048; u.ldb = 2048; u.O = (bf16_t*)(ws + B_VTA); u.r0 = 256 * sub;
            } else {
                const int g = sub - 2, r = 1 << (2 * g), b = it >> 5, idx = it & 31, per = 32 >> (2 * g), rho = idx / per, p0 = (idx % per) * 256;
                u.A = wt + (size_t)(3072 + 256 * g) * 2048; u.B = xb + (size_t)(b * SEQ + p0 * r + rho) * 2048; u.ldb = 2048u * (unsigned)r;
                u.O = (bf16_t*)(ws + B_VTD); u.r0 = 256 * g;
            }
        }
        return true;
    }
};
}

__device__ __forceinline__ int crow(int r, int hi) { return (r & 3) + 8 * (r >> 2) + 4 * hi; }
struct AttnSt { f32x16 o0, o1; float m, l; };
struct Frags { bf16x8 k[4]; s16x4 v0[4]; s16x4 v1[4]; };

__device__ __forceinline__ void load_frags(Frags& f, const bf16_t* kp, const bf16_t* v0p, const bf16_t* v1p) {
#pragma unroll
    for (int d0 = 0; d0 < 4; ++d0) f.k[d0] = *(const bf16x8*)(kp + 16 * d0);
#pragma unroll
    for (int j = 0; j < 4; ++j) { f.v0[j] = *(const s16x4*)(v0p + 8 * j); f.v1[j] = *(const s16x4*)(v1p + 8 * j); }
}
#define CAT8(a, b) (bf16x8){a[0], a[1], a[2], a[3], b[0], b[1], b[2], b[3]}
__device__ __forceinline__ void attn_step(AttnSt& st, const bf16x8 (&qf)[4], const Frags& f, int kvbase, int hi, int lo_b, int hi_b) {
    f32x16 p;
#pragma unroll
    for (int r = 0; r < 16; ++r) p[r] = 0.f;
#pragma unroll
    for (int d0 = 0; d0 < 4; ++d0) p = __builtin_amdgcn_mfma_f32_32x32x16_bf16(f.k[d0], qf[d0], p, 0, 0, 0);
    const float C2 = 0.125f * 1.44269504089f;
    float mx = -INFINITY;
#pragma unroll
    for (int r = 0; r < 16; ++r) { const int kv = kvbase + crow(r, hi); float s = p[r] * C2; s = (kv >= lo_b && kv <= hi_b) ? s : -INFINITY; p[r] = s; mx = fmaxf(mx, s); }
    mx = fmaxf(mx, __shfl_xor(mx, 32));
    const float mn = fmaxf(st.m, mx);
    const float alpha = __builtin_amdgcn_exp2f(st.m - mn);
    float ps = 0.f;
#pragma unroll
    for (int r = 0; r < 16; ++r) { p[r] = __builtin_amdgcn_exp2f(p[r] - mn); ps += p[r]; }
    st.l = st.l * alpha + ps; st.m = mn;
#pragma unroll
    for (int r = 0; r < 16; ++r) { st.o0[r] *= alpha; st.o1[r] *= alpha; }
    u32x4 wa, wb;
    wa.x = cvtpk(p[0], p[1]); wa.y = cvtpk(p[2], p[3]); wa.z = cvtpk(p[4], p[5]); wa.w = cvtpk(p[6], p[7]);
    wb.x = cvtpk(p[8], p[9]); wb.y = cvtpk(p[10], p[11]); wb.z = cvtpk(p[12], p[13]); wb.w = cvtpk(p[14], p[15]);
    const bf16x8 pa = __builtin_bit_cast(bf16x8, wa), pb = __builtin_bit_cast(bf16x8, wb);
    st.o0 = __builtin_amdgcn_mfma_f32_32x32x16_bf16(CAT8(f.v0[0], f.v0[1]), pa, st.o0, 0, 0, 0);
    st.o0 = __builtin_amdgcn_mfma_f32_32x32x16_bf16(CAT8(f.v0[2], f.v0[3]), pb, st.o0, 0, 0, 0);
    st.o1 = __builtin_amdgcn_mfma_f32_32x32x16_bf16(CAT8(f.v1[0], f.v1[1]), pa, st.o1, 0, 0, 0);
    st.o1 = __builtin_amdgcn_mfma_f32_32x32x16_bf16(CAT8(f.v1[2], f.v1[3]), pb, st.o1, 0, 0, 0);
}
__device__ __forceinline__ void attn_init(AttnSt& st) {
#pragma unroll
    for (int r = 0; r < 16; ++r) { st.o0[r] = 0.f; st.o1[r] = 0.f; }
    st.m = -1e30f; st.l = 0.f;
}
__device__ __forceinline__ float attn_store(const AttnSt& st, bf16_t* orow, int hi, bool dry = false) {
    const float lt = st.l + __shfl_xor(st.l, 32);
    const float inv = 1.0f / lt;
    if (dry && lt > -1.0f) return lt;
#pragma unroll
    for (int g4 = 0; g4 < 4; ++g4) {
        u32x2 a, b;
        a.x = cvtpk(st.o0[4 * g4] * inv, st.o0[4 * g4 + 1] * inv); a.y = cvtpk(st.o0[4 * g4 + 2] * inv, st.o0[4 * g4 + 3] * inv);
        b.x = cvtpk(st.o1[4 * g4] * inv, st.o1[4 * g4 + 1] * inv); b.y = cvtpk(st.o1[4 * g4 + 2] * inv, st.o1[4 * g4 + 3] * inv);
        *(u32x2*)(orow + 8 * g4 + 4 * hi) = a;
        *(u32x2*)(orow + 32 + 8 * g4 + 4 * hi) = b;
    }
    return lt;
}

__device__ __forceinline__ void moba_tile(unsigned char* ws, int b, int h, int qblk, int w, int lane, bool dry = false) {
    const int l31 = lane & 31, hi = lane >> 5;
    const int q = qblk * 256 + w * 32 + l31;
    bf16_t* Qrow = (bf16_t*)(ws + B_QA) + (size_t)(b * SEQ + q) * 512 + h * 64;
    const bf16_t* Kl = (const bf16_t*)(ws + B_KA) + (size_t)(b * SEQ + l31) * 512 + h * 64 + 8 * hi;
    const bf16_t* V0 = (const bf16_t*)(ws + B_VTA) + (size_t)(h * 64 + l31) * 16384 + b * SEQ + 4 * hi;
    const bf16_t* V1 = V0 + (size_t)32 * 16384;
    unsigned mask = 0u;
    if (qblk > 0) {
        float qv[32];
#pragma unroll
        for (int c4 = 0; c4 < 4; ++c4) { const u32x4 t = *(const u32x4*)(Qrow + 32 * hi + 8 * c4);
            qv[8 * c4 + 0] = bflo(t.x); qv[8 * c4 + 1] = bfhi(t.x); qv[8 * c4 + 2] = bflo(t.y); qv[8 * c4 + 3] = bfhi(t.y);
            qv[8 * c4 + 4] = bflo(t.z); qv[8 * c4 + 5] = bfhi(t.z); qv[8 * c4 + 6] = bflo(t.w); qv[8 * c4 + 7] = bfhi(t.w); }
        const float* km = (const float*)(ws + WS_KMEAN) + (size_t)((b * 8 + h) * 32) * 64 + 32 * hi;
        float g[32];
#pragma unroll
        for (int j = 0; j < 32; ++j) {
            float s = 0.f;
            if (j < qblk) {
#pragma unroll
                for (int d4 = 0; d4 < 8; ++d4) { const f32x4 kk = *(const f32x4*)(km + j * 64 + 4 * d4);
                    s += qv[4 * d4] * kk[0] + qv[4 * d4 + 1] * kk[1] + qv[4 * d4 + 2] * kk[2] + qv[4 * d4 + 3] * kk[3]; }
            }
            g[j] = s + __shfl_xor(s, 32);
        }
#pragma unroll
        for (int pass = 0; pass < 3; ++pass) {
            float best = -INFINITY; int bi = -1;
#pragma unroll
            for (int j = 0; j < 32; ++j) { const bool ok = (j < qblk) && !((mask >> j) & 1u) && (g[j] > best); best = ok ? g[j] : best; bi = ok ? j : bi; }
            if (bi >= 0) mask |= 1u << bi;
        }
    }
    unsigned need = 0u;
    for (int j = 0; j < qblk; ++j) if (__any((int)((mask >> j) & 1u))) need |= 1u << j;
    need |= 1u << qblk;
    bf16x8 qf[4];
#pragma unroll
    for (int d0 = 0; d0 < 4; ++d0) qf[d0] = *(const bf16x8*)(Qrow + 16 * d0 + 8 * hi);
    AttnSt st; attn_init(st);
    int blk = __builtin_ctz(need); need &= need - 1u; int i = 0;
    Frags f, fn;
    { const int kv = blk * 256; load_frags(f, Kl + (size_t)kv * 512, V0 + kv, V1 + kv); }
    for (;;) {
        const int nst = (blk == qblk) ? (w + 1) : 8;
        int nblk = blk, ni = i + 1; bool has = true;
        if (ni >= nst) { if (need == 0u) has = false; else { nblk = __builtin_ctz(need); need &= need - 1u; ni = 0; } }
        if (has) { const int kv = nblk * 256 + ni * 32; load_frags(fn, Kl + (size_t)kv * 512, V0 + kv, V1 + kv); }
        const bool own = (blk == qblk);
        const bool sel = own || ((mask >> blk) & 1u);
        const int lo_b = sel ? -1 : 0x7fffffff, hi_b = own ? q : 0x7ffffff0;
        attn_step(st, qf, f, blk * 256 + i * 32, hi, lo_b, hi_b);
        if (!has) break;
        f = fn; blk = nblk; i = ni;
    }
    attn_store(st, Qrow, hi, dry);
}

template <bool DIAG>
__device__ __forceinline__ void attn_step2(AttnSt& st, const bf16x8 (&qf)[4], const Frags& f, int kvbase, int hi, bool sel, int q) {
    f32x16 p;
#pragma unroll
    for (int r = 0; r < 16; ++r) p[r] = 0.f;
#pragma unroll
    for (int d0 = 0; d0 < 4; ++d0) p = __builtin_amdgcn_mfma_f32_32x32x16_bf16(f.k[d0], qf[d0], p, 0, 0, 0);
    const float C2 = 0.125f * 1.44269504089f;
    float mx = -INFINITY;
#pragma unroll
    for (int r = 0; r < 16; ++r) { float s = p[r] * C2; if (DIAG) { const int kv = kvbase + crow(r, hi); s = (kv <= q) ? s : -INFINITY; } p[r] = s; mx = fmaxf(mx, s); }
    if (!DIAG) mx = sel ? mx : -INFINITY;
    mx = fmaxf(mx, __shfl_xor(mx, 32));
    const float mn = fmaxf(st.m, mx);
    const float alpha = __builtin_amdgcn_exp2f(st.m - mn);
    const float mne = (DIAG || sel) ? mn : INFINITY;
    float ps = 0.f;
#pragma unroll
    for (int r = 0; r < 16; ++r) { p[r] = __builtin_amdgcn_exp2f(p[r] - mne); ps += p[r]; }
    st.l = st.l * alpha + ps; st.m = mn;
#pragma unroll
    for (int r = 0; r < 16; ++r) { st.o0[r] *= alpha; st.o1[r] *= alpha; }
    u32x4 wa, wb;
    wa.x = cvtpk(p[0], p[1]); wa.y = cvtpk(p[2], p[3]); wa.z = cvtpk(p[4], p[5]); wa.w = cvtpk(p[6], p[7]);
    wb.x = cvtpk(p[8], p[9]); wb.y = cvtpk(p[10], p[11]); wb.z = cvtpk(p[12], p[13]); wb.w = cvtpk(p[14], p[15]);
    const bf16x8 pa = __builtin_bit_cast(bf16x8, wa), pb = __builtin_bit_cast(bf16x8, wb);
    st.o0 = __builtin_amdgcn_mfma_f32_32x32x16_bf16(CAT8(f.v0[0], f.v0[1]), pa, st.o0, 0, 0, 0);
    st.o0 = __builtin_amdgcn_mfma_f32_32x32x16_bf16(CAT8(f.v0[2], f.v0[3]), pb, st.o0, 0, 0, 0);
    st.o1 = __builtin_amdgcn_mfma_f32_32x32x16_bf16(CAT8(f.v1[0], f.v1[1]), pa, st.o1, 0, 0, 0);
    st.o1 = __builtin_amdgcn_mfma_f32_32x32x16_bf16(CAT8(f.v1[2], f.v1[3]), pb, st.o1, 0, 0, 0);
}
struct TileGen { unsigned rem; int blk, sub; bool valid; };
__device__ __forceinline__ void tg_init(TileGen& g, unsigned need) { g.blk = __builtin_ctz(need); g.rem = need & (need - 1u); g.sub = 0; g.valid = true; }
__device__ __forceinline__ void tg_next(TileGen& g) { if (++g.sub == 4) { g.sub = 0; if (g.rem == 0u) g.valid = false; else { g.blk = __builtin_ctz(g.rem); g.rem &= g.rem - 1u; } } }

__device__ __forceinline__ void moba_unit(unsigned char* ws, LAS unsigned char* lds, volatile LAS unsigned* MISC, int b, int h, int qblk, int w, int lane, int tid) {
    const int l31 = lane & 31, hi = lane >> 5;
    const int q = qblk * 256 + w * 32 + l31;
    bf16_t* Qrow = (bf16_t*)(ws + B_QA) + (size_t)(b * SEQ + q) * 512 + h * 64;
    unsigned mask = 0u;
    if (qblk > 0) {
        float qv[32];
#pragma unroll
        for (int c4 = 0; c4 < 4; ++c4) { const u32x4 t = *(const u32x4*)(Qrow + 32 * hi + 8 * c4);
            qv[8 * c4 + 0] = bflo(t.x); qv[8 * c4 + 1] = bfhi(t.x); qv[8 * c4 + 2] = bflo(t.y); qv[8 * c4 + 3] = bfhi(t.y);
            qv[8 * c4 + 4] = bflo(t.z); qv[8 * c4 + 5] = bfhi(t.z); qv[8 * c4 + 6] = bflo(t.w); qv[8 * c4 + 7] = bfhi(t.w); }
        const float* km = (const float*)(ws + WS_KMEAN) + (size_t)((b * 8 + h) * 32) * 64 + 32 * hi;
        float g[32];
#pragma unroll
        for (int j = 0; j < 32; ++j) {
            float s = 0.f;
            if (j < qblk) {
#pragma unroll
                for (int d4 = 0; d4 < 8; ++d4) { const f32x4 kk = *(const f32x4*)(km + j * 64 + 4 * d4);
                    s += qv[4 * d4] * kk[0] + qv[4 * d4 + 1] * kk[1] + qv[4 * d4 + 2] * kk[2] + qv[4 * d4 + 3] * kk[3]; }
            }
            g[j] = s + __shfl_xor(s, 32);
        }
#pragma unroll
        for (int pass = 0; pass < 3; ++pass) {
            float best = -INFINITY; int bi = -1;
#pragma unroll
            for (int j = 0; j < 32; ++j) { const bool ok = (j < qblk) && !((mask >> j) & 1u) && (g[j] > best); best = ok ? g[j] : best; bi = ok ? j : bi; }
            if (bi >= 0) mask |= 1u << bi;
        }
    }
    unsigned need_w = 0u;
    for (int j = 0; j < qblk; ++j) if (__any((int)((mask >> j) & 1u))) need_w |= 1u << j;
    if (lane == 0) MISC[16 + w] = need_w;
    bf16x8 qf[4];
#pragma unroll
    for (int d0 = 0; d0 < 4; ++d0) qf[d0] = *(const bf16x8*)(Qrow + 16 * d0 + 8 * hi);
    __syncthreads();
    unsigned need = 1u << qblk;
#pragma unroll
    for (int i = 0; i < 8; ++i) need |= MISC[16 + i];
    need = __builtin_amdgcn_readfirstlane(need);
    AttnSt st; attn_init(st);
    const int srow = tid >> 3, sc = tid & 7;
    const bf16_t* gK = (const bf16_t*)(ws + B_KA) + (size_t)(b * SEQ + srow) * 512 + h * 64 + 8 * sc;
    const bf16_t* gV = (const bf16_t*)(ws + B_VTA) + (size_t)(h * 64 + srow) * 16384 + b * SEQ + 8 * sc;
    const int woff = srow * 128 + ((sc ^ (srow & 7)) << 4);
#define MU_ISSUE(g, rk, rv) do { const int kv0_ = (g).blk * 256 + (g).sub * 64; rk = *(const u32x4*)(gK + (size_t)kv0_ * 512); rv = *(const u32x4*)(gV + kv0_); } while (0)
#define MU_WRITE(slot, rk, rv) do { *(LAS u32x4*)(lds + (slot) * 16384 + woff) = rk; *(LAS u32x4*)(lds + (slot) * 16384 + 8192 + woff) = rv; } while (0)
#define MU_COMPUTE(g, slot) do { const int blk_ = (g).blk; const bool own_ = (blk_ == qblk); \
        const bool sel_ = own_ || ((mask >> blk_) & 1u); const bool wn_ = own_ || ((need_w >> blk_) & 1u); \
        _Pragma("unroll") for (int i_ = 0; i_ < 2; ++i_) { const int si_ = (g).sub * 2 + i_; \
            if (wn_ && (!own_ || si_ <= w)) { Frags f_; const int kvr_ = 32 * i_ + l31; \
                _Pragma("unroll") for (int d0 = 0; d0 < 4; ++d0) f_.k[d0] = *(const LAS bf16x8*)(lds + (slot) * 16384 + kvr_ * 128 + (((2 * d0 + hi) ^ (kvr_ & 7)) << 4)); \
                _Pragma("unroll") for (int j_ = 0; j_ < 4; ++j_) { \
                    f_.v0[j_] = *(const LAS s16x4*)(lds + (slot) * 16384 + 8192 + l31 * 128 + (((4 * i_ + j_) ^ (l31 & 7)) << 4) + 8 * hi); \
                    f_.v1[j_] = *(const LAS s16x4*)(lds + (slot) * 16384 + 8192 + (l31 + 32) * 128 + (((4 * i_ + j_) ^ (l31 & 7)) << 4) + 8 * hi); } \
                if (own_ && si_ == w) attn_step2<true>(st, qf, f_, blk_ * 256 + si_ * 32, hi, true, q); \
                else attn_step2<false>(st, qf, f_, blk_ * 256 + si_ * 32, hi, sel_, q); } } } while (0)
    TileGen gi; tg_init(gi, need);
    TileGen gc = gi;
    u32x4 rk0, rv0, rk1, rv1;
    MU_ISSUE(gi, rk0, rv0); tg_next(gi);
    MU_ISSUE(gi, rk1, rv1); tg_next(gi);
    MU_WRITE(0, rk0, rv0);
    __syncthreads();
    for (;;) {
        if (gi.valid) { MU_ISSUE(gi, rk0, rv0); tg_next(gi); }
        MU_COMPUTE(gc, 0); tg_next(gc);
        if (!gc.valid) break;
        MU_WRITE(1, rk1, rv1);
        __syncthreads();
        if (gi.valid) { MU_ISSUE(gi, rk1, rv1); tg_next(gi); }
        MU_COMPUTE(gc, 1); tg_next(gc);
        if (!gc.valid) break;
        MU_WRITE(0, rk0, rv0);
        __syncthreads();
    }
#undef MU_ISSUE
#undef MU_WRITE
#undef MU_COMPUTE
    attn_store(st, Qrow, hi);
    __syncthreads();
}

__device__ __forceinline__ void dil_tile(unsigned char* ws, int tile, int lane, bool dry = false) {
    const int l31 = lane & 31, hi = lane >> 5;
    const int b = tile / 3072, rem = tile % 3072, hd = rem >> 8, t = rem & 255, g = hd >> 2, sh = 2 * g, r = 1 << sh;
    const int len = SEQ >> sh, tpr = len >> 5, rho = t / tpr, p0 = (t % tpr) * 32;
    const int p = p0 + l31, tok = p * r + rho;
    bf16_t* Qrow = (bf16_t*)(ws + B_QD) + (size_t)(b * SEQ + tok) * 768 + hd * 64;
    const bf16_t* Kl = (const bf16_t*)(ws + B_KD) + (size_t)(b * SEQ + rho) * 768 + hd * 64 + 8 * hi;
    const bf16_t* V0 = (const bf16_t*)(ws + B_VTD) + (size_t)(hd * 64 + l31) * 16384 + b * SEQ + rho * len + 4 * hi;
    const bf16_t* V1 = V0 + (size_t)32 * 16384;
    bf16x8 qf[4];
#pragma unroll
    for (int d0 = 0; d0 < 4; ++d0) qf[d0] = *(const bf16x8*)(Qrow + 16 * d0 + 8 * hi);
    AttnSt st; attn_init(st);
    int s = (p0 >= 128) ? 0 : ((128 - p0) >> 5);
    Frags f, fn;
    { const int kv = p0 - 128 + 32 * s; load_frags(f, Kl + (size_t)((kv + l31) * r) * 768, V0 + kv, V1 + kv); }
    for (;;) {
        const bool has = (s + 1) < 5;
        if (has) { const int kv = p0 - 128 + 32 * (s + 1); load_frags(fn, Kl + (size_t)((kv + l31) * r) * 768, V0 + kv, V1 + kv); }
        attn_step(st, qf, f, p0 - 128 + 32 * s, hi, p - 128, p);
        if (!has) break;
        f = fn; ++s;
    }
    const float lt = attn_store(st, Qrow, hi, dry);
    if (hi == 0 && !dry) ((float*)(ws + WS_LSE))[(size_t)(b * SEQ + tok) * 12 + hd] = 0.69314718056f * (st.m + __builtin_amdgcn_logf(lt));
}

__device__ __forceinline__ float wave_sum(float v) {
#pragma unroll
    for (int o = 1; o < 64; o <<= 1) v += __shfl_xor(v, o);
    return v;
}
__device__ __forceinline__ void transpose_item(const float* W, int K, int N, bf16_t* WT, LAS float* scr, int item, int lane) {
    const int nblk = N / 32, kb = item / nblk, nb = item % nblk, k0 = 64 * kb, n0 = 32 * nb;
#pragma unroll 8
    for (int i = 0; i < 32; ++i) { const int kk = 2 * i + (lane >> 5); scr[kk * 33 + (lane & 31)] = W[(size_t)(k0 + kk) * N + n0 + (lane & 31)]; }
    asm volatile("s_waitcnt lgkmcnt(0)" ::: "memory");
    const int c = lane & 7;
#pragma unroll
    for (int j = 0; j < 4; ++j) { const int n = (lane >> 3) + 8 * j; const LAS float* s = scr + (8 * c) * 33 + n;
        u32x4 o; o.x = cvtpk(s[0 * 33], s[1 * 33]); o.y = cvtpk(s[2 * 33], s[3 * 33]); o.z = cvtpk(s[4 * 33], s[5 * 33]); o.w = cvtpk(s[6 * 33], s[7 * 33]);
        *(u32x4*)(WT + (size_t)(n0 + n) * K + k0 + 8 * c) = o; }
    asm volatile("s_waitcnt lgkmcnt(0)" ::: "memory");
}

#define XB_TMO      128
#define XB_XCNT(j)  (256  + 64 * (j))
#define XB_XSUB(j)  (1280 + 64 * (j))
#define XB_XGEN(j)  (2304 + 64 * (j))
#define XB_TOP      3328
#define XB_TOPGEN   3392
#define XCD_BAR_WORDS 3456
#define XB_SPIN_CAP (1u << 22)
__device__ __forceinline__ unsigned xb_ld(unsigned* p)              { return __hip_atomic_load(p, __ATOMIC_RELAXED, __HIP_MEMORY_SCOPE_AGENT); }
__device__ __forceinline__ unsigned xb_add(unsigned* p, unsigned v) { return __hip_atomic_fetch_add(p, v, __ATOMIC_RELAXED, __HIP_MEMORY_SCOPE_AGENT); }
__device__ __forceinline__ unsigned xb_xcc_id() { return (unsigned)__builtin_amdgcn_s_getreg((3 << 11) | 20) & 0xFu; }
#define XB_SPIN(cond, bar) do { unsigned _sp = 0; while (cond) { __builtin_amdgcn_s_sleep(1); \
    if ((++_sp & 255u) == 0u) { if (xb_ld(&(bar)[XB_TMO])) break; if (_sp > XB_SPIN_CAP) { atomicAdd(&(bar)[XB_TMO], 1u); break; } } } } while (0)
struct XcdBarrier { unsigned* bar; unsigned x; volatile LAS unsigned* st; };
__device__ __forceinline__ XcdBarrier xcd_barrier_post(unsigned* bar, volatile LAS unsigned* st) {
    XcdBarrier b; b.bar = bar; b.x = xb_xcc_id(); b.st = st;
    if (threadIdx.x == 0) (void)xb_add(&bar[XB_XCNT(b.x)], 1u);
    return b;
}
__device__ __forceinline__ void xcd_barrier_complete(unsigned* bar, unsigned x, unsigned& nloc, unsigned& nx) {
    const unsigned G = gridDim.x * gridDim.y * gridDim.z;
    unsigned sum, cnt, mine, sp = 0u;
    for (;;) {
        sum = 0u; cnt = 0u; mine = 0u;
#pragma unroll
        for (unsigned j = 0; j < 16; ++j) { const unsigned c = xb_ld(&bar[XB_XCNT(j)]); sum += c; cnt += (c > 0u) ? 1u : 0u; mine = (j == x) ? c : mine; }
        if (sum == G) break;
        __builtin_amdgcn_s_sleep(1);
        if ((++sp & 255u) == 0u) { if (xb_ld(&bar[XB_TMO])) break; if (sp > XB_SPIN_CAP) { atomicAdd(&bar[XB_TMO], 1u); break; } }
    }
    nloc = mine > 0u ? mine : 1u; nx = cnt > 0u ? cnt : 1u;
}
__device__ __forceinline__ void xcd_barrier(const XcdBarrier& b) {
    asm volatile("s_waitcnt vmcnt(0)" ::: "memory");
    __syncthreads();
    if (threadIdx.x == 0) {
        unsigned* bar = b.bar;
        __builtin_amdgcn_s_waitcnt(0);
        unsigned nloc = b.st[0], nx = b.st[1];
        if (nloc == 0u) { xcd_barrier_complete(bar, b.x, nloc, nx); b.st[0] = nloc; b.st[1] = nx; }
        const unsigned old = xb_add(&bar[XB_XSUB(b.x)], 1u);
        const unsigned gen = old / nloc;
        if (old + 1u == (gen + 1u) * nloc) {
            __builtin_amdgcn_fence(__ATOMIC_RELEASE, "agent");
            asm volatile("s_waitcnt vmcnt(0)" ::: "memory");
            const unsigned og = xb_add(&bar[XB_TOP], 1u);
            const unsigned tg = og / nx;
            if (og + 1u == (tg + 1u) * nx) xb_add(&bar[XB_TOPGEN], 1u);
            else XB_SPIN(xb_ld(&bar[XB_TOPGEN]) == tg, bar);
            __builtin_amdgcn_fence(__ATOMIC_ACQUIRE, "agent");
            xb_add(&bar[XB_XGEN(b.x)], 1u);
            asm volatile("s_waitcnt vmcnt(0)" ::: "memory");
        } else {
            XB_SPIN(xb_ld(&bar[XB_XGEN(b.x)]) == gen, bar);
            __builtin_amdgcn_fence(__ATOMIC_ACQUIRE, "agent");
            asm volatile("s_waitcnt vmcnt(0)" ::: "memory");
        }
    }
    __syncthreads();
}

struct Params { const float* in[15]; float* out; unsigned char* ws; int ph_lo, ph_hi; };

__global__ void __launch_bounds__(512, 2) mega_fwd(Params P) {
    extern __shared__ __attribute__((aligned(16))) unsigned char lds_raw[];
    LAS unsigned char* lds = (LAS unsigned char*)lds_raw;
    cg::grid_group grid = cg::this_grid();
    volatile LAS unsigned* MISC = (volatile LAS unsigned*)(lds + 131072);
    if (threadIdx.x < 64) MISC[threadIdx.x] = 0u;
    __syncthreads();
    XcdBarrier xbar = xcd_barrier_post((unsigned*)((GAS unsigned char*)P.ws), MISC + 8);
    for (int ph = P.ph_lo; ph < P.ph_hi; ++ph) {
        int tid = threadIdx.x; asm volatile("" : "+v"(tid));
        size_t zoff = 0; asm volatile("" : "+s"(zoff));
        unsigned char* ws = (unsigned char*)((GAS unsigned char*)P.ws + zoff);
        float* outp = (float*)((GAS float*)P.out + zoff);
#define INP(i) ((const float*)((const GAS float*)P.in[i] + zoff))
        int G = gridDim.x, wg = blockIdx.x; asm volatile("" : "+s"(G), "+s"(wg));
        const int lane = tid & 63, wave = __builtin_amdgcn_readfirstlane(tid >> 6);
        const int gw = wg * 8 + wave, NGW = G * 8;
        const int gt = wg * 512 + tid, NGT = G * 512;
        bf16_t* XB = (bf16_t*)(ws + WS_XB);
        const int l = ph / NPH_LAYER, k = ph % NPH_LAYER;
        const float* xres = (l == 0) ? INP(0) : outp;
#ifdef ONLY
        if (k != ONLY) continue;
#endif
#ifdef SKIPK
        if (k == SKIPK) continue;
#endif
#ifdef SKIPK2
        if (k == SKIPK2) continue;
#endif
        switch (k) {
        case 0: {
            LAS float* scr = (LAS float*)(lds + wave * 16384);
            const int I0 = 16 * 264, I1 = 8 * 32, I2 = 8 * 32, I3 = 4 * 32, I4 = 16 * 32, I5 = 16 * 176, I6 = 44 * 32;
            const int NIT = I0 + I1 + I2 + I3 + I4 + I5 + I6;
            for (int it = gw; it < NIT; it += NGW) {
                int r = it;
                if (r < I0) { transpose_item(INP(1) + (size_t)l * DM * INC, DM, INC, (bf16_t*)(ws + W_IN), scr, r, lane); continue; } r -= I0;
                if (r < I1) { transpose_item(INP(3) + (size_t)l * 512 * DM, 512, DM, (bf16_t*)(ws + W_MOBA), scr, r, lane); continue; } r -= I1;
                if (r < I2) { transpose_item(INP(5) + (size_t)l * 512 * DM, 512, DM, (bf16_t*)(ws + W_CONV), scr, r, lane); continue; } r -= I2;
                if (r < I3) { transpose_item(INP(4) + (size_t)l * 256 * DM, 256, DM, (bf16_t*)(ws + W_DIL), scr, r, lane); continue; } r -= I3;
                if (r < I4) { transpose_item(INP(6) + (size_t)l * DM * DM, DM, DM, (bf16_t*)(ws + W_MIX), scr, r, lane); continue; } r -= I4;
                if (r < I5) { transpose_item(INP(9) + (size_t)l * DM * DFF2, DM, DFF2, (bf16_t*)(ws + W_UP), scr, r, lane); continue; } r -= I5;
                transpose_item(INP(12) + (size_t)l * DFF * DM, DFF, DM, (bf16_t*)(ws + W_DOWN), scr, r, lane);
            }
            if (l == 0) {
                const float* x = INP(0);
                for (int it = gt; it < M_TOK * DM / 8; it += NGT) {
                    const f32x4 a = *(const f32x4*)(x + (size_t)it * 8), c = *(const f32x4*)(x + (size_t)it * 8 + 4);
                    u32x4 o; o.x = cvtpk(a[0], a[1]); o.y = cvtpk(a[2], a[3]); o.z = cvtpk(c[0], c[1]); o.w = cvtpk(c[2], c[3]);
                    *(u32x4*)(XB + (size_t)it * 8) = o;
                }
            }
        } break;
        case 1: {
            pg8::SchedIN S{G, wg, (const char*)XB, (const char*)(ws + W_IN), ws};
            pg8::EpiBf16<0> E;
            pg8::gemm_phase(lds, tid, DM, 2048u, S, E);
        } break;
        case 2: {
            {
                LAS float* red = (LAS float*)lds;
                const bf16_t* KA = (const bf16_t*)(ws + B_KA);
                for (int it = wg; it < 256; it += G) {
                    const int b = it >> 7, j = (it >> 2) & 31, cgp = it & 3;
                    const int col = cgp * 128 + (tid & 127), rp = tid >> 7;
                    const bf16_t* src = KA + (size_t)(b * SEQ + j * 256 + rp * 64) * 512 + col;
                    float s = 0.f;
                    for (int rr = 0; rr < 64; ++rr) s += __uint_as_float((unsigned)src[(size_t)rr * 512] << 16);
                    __syncthreads();
                    red[tid] = s;
                    __syncthreads();
                    if (tid < 128) {
                        const float tot = (red[tid] + red[tid + 128]) + (red[tid + 256] + red[tid + 384]);
                        const int hh = col >> 6, d = col & 63;
                        ((float*)(ws + WS_KMEAN))[(size_t)((b * 8 + hh) * 32 + j) * 64 + d] = tot * (1.0f / 256.0f);
                    }
                }
            }
            {
                bf16_t* BC = (bf16_t*)(ws + B_BC); const bf16_t* CCp = (const bf16_t*)(ws + B_CC); const bf16_t* HHp = (const bf16_t*)(ws + B_HH);
                const float* wsc = INP(2) + (size_t)l * 3 * 512;
                for (int it = gt; it < M_TOK * 64; it += NGT) {
                    const int row = it >> 6, c8 = (it & 63) * 8, tpos = row & (SEQ - 1);
                    float accv[8];
#pragma unroll
                    for (int e = 0; e < 8; ++e) accv[e] = 0.f;
#pragma unroll
                    for (int j = 0; j < 3; ++j) {
                        if (tpos >= j) {
                            const u32x4 cv = *(const u32x4*)(CCp + (size_t)(row - j) * 512 + c8), hv = *(const u32x4*)(HHp + (size_t)(row - j) * 512 + c8);
                            const f32x4 w0 = *(const f32x4*)(wsc + j * 512 + c8), w1 = *(const f32x4*)(wsc + j * 512 + c8 + 4);
                            accv[0] += w0[0] * bflo(cv.x) * bflo(hv.x); accv[1] += w0[1] * bfhi(cv.x) * bfhi(hv.x);
                            accv[2] += w0[2] * bflo(cv.y) * bflo(hv.y); accv[3] += w0[3] * bfhi(cv.y) * bfhi(hv.y);
                            accv[4] += w1[0] * bflo(cv.z) * bflo(hv.z); accv[5] += w1[1] * bfhi(cv.z) * bfhi(hv.z);
                            accv[6] += w1[2] * bflo(cv.w) * bflo(hv.w); accv[7] += w1[3] * bfhi(cv.w) * bfhi(hv.w);
                        }
                    }
                    const u32x4 bv = *(const u32x4*)(BC + (size_t)row * 512 + c8);
                    u32x4 o;
                    o.x = cvtpk(bflo(bv.x) * accv[0], bfhi(bv.x) * accv[1]); o.y = cvtpk(bflo(bv.y) * accv[2], bfhi(bv.y) * accv[3]);
                    o.z = cvtpk(bflo(bv.z) * accv[4], bfhi(bv.z) * accv[5]); o.w = cvtpk(bflo(bv.w) * accv[6], bfhi(bv.w) * accv[7]);
                    *(u32x4*)(BC + (size_t)row * 512 + c8) = o;
                }
            }
        } break;
        case 3: {
            const int vcu = (G % 8 == 0) ? (wg % 8) * (G / 8) + wg / 8 : wg;
            for (int uidx = vcu; uidx < 256; uidx += G) {
                const int bh = uidx >> 4, s = uidx & 15;
                moba_unit(ws, lds, MISC, bh >> 3, bh & 7, s, wave, lane, tid);
                moba_unit(ws, lds, MISC, bh >> 3, bh & 7, 31 - s, wave, lane, tid);
            }
            { const int per = (6144 + NGW - 1) / NGW, t0 = (vcu * 8 + wave) * per;
              for (int t = t0; t < t0 + per && t < 6144; ++t) dil_tile(ws, t, lane); }
        } break;
        case 4: {
            {
                const bf16_t* QD = (const bf16_t*)(ws + B_QD); const float* LSE = (const float*)(ws + WS_LSE); bf16_t* YD = (bf16_t*)(ws + B_YD);
                for (int it = gt; it < M_TOK * 32; it += NGT) {
                    const int row = it >> 5, hh = (it >> 3) & 3, d8 = (it & 7) * 8;
                    const float l0 = LSE[(size_t)row * 12 + hh], l1 = LSE[(size_t)row * 12 + 4 + hh], l2 = LSE[(size_t)row * 12 + 8 + hh];
                    const float mx = fmaxf(l0, fmaxf(l1, l2));
                    float e0 = __expf(l0 - mx), e1 = __expf(l1 - mx), e2 = __expf(l2 - mx);
                    const float inv = 1.0f / (e0 + e1 + e2); e0 *= inv; e1 *= inv; e2 *= inv;
                    const u32x4 a = *(const u32x4*)(QD + (size_t)row * 768 + hh * 64 + d8), bq = *(const u32x4*)(QD + (size_t)row * 768 + 256 + hh * 64 + d8),
                                c = *(const u32x4*)(QD + (size_t)row * 768 + 512 + hh * 64 + d8);
                    u32x4 o;
                    o.x = cvtpk(e0 * bflo(a.x) + e1 * bflo(bq.x) + e2 * bflo(c.x), e0 * bfhi(a.x) + e1 * bfhi(bq.x) + e2 * bfhi(c.x));
                    o.y = cvtpk(e0 * bflo(a.y) + e1 * bflo(bq.y) + e2 * bflo(c.y), e0 * bfhi(a.y) + e1 * bfhi(bq.y) + e2 * bfhi(c.y));
                    o.z = cvtpk(e0 * bflo(a.z) + e1 * bflo(bq.z) + e2 * bflo(c.z), e0 * bfhi(a.z) + e1 * bfhi(bq.z) + e2 * bfhi(c.z));
                    o.w = cvtpk(e0 * bflo(a.w) + e1 * bflo(bq.w) + e2 * bflo(c.w), e0 * bfhi(a.w) + e1 * bfhi(bq.w) + e2 * bfhi(c.w));
                    *(u32x4*)(YD + (size_t)row * 256 + hh * 64 + d8) = o;
                }
            }
            pg8::SchedSimple S{64, 12, G, wg, (const char*)XB, (size_t)256 * 2048, (const char*)(ws + W_IN) + (size_t)5376 * 2048, (size_t)256 * 2048, 2048u, (bf16_t*)(ws + B_G), 3072};
            pg8::EpiBf16<1> E;
            pg8::gemm_phase(lds, tid, DM, 2048u, S, E);
        } break;
        case 5: {
            bf16_t* MG = XB;
            { pg8::SchedSimple S{64, 4, G, wg, (const char*)(ws + B_QA), (size_t)256 * 1024, (const char*)(ws + W_MOBA), (size_t)256 * 1024, 1024u, MG, 1024};
              pg8::EpiMerge<true> E{(const bf16_t*)(ws + B_G), MG, 0}; pg8::gemm_phase(lds, tid, 512, 1024u, S, E); }
            { pg8::SchedSimple S{64, 4, G, wg, (const char*)(ws + B_BC), (size_t)256 * 1024, (const char*)(ws + W_CONV), (size_t)256 * 1024, 1024u, MG, 1024};
              pg8::EpiMerge<false> E{(const bf16_t*)(ws + B_G), MG, 1}; pg8::gemm_phase(lds, tid, 512, 1024u, S, E); }
            { pg8::SchedSimple S{64, 4, G, wg, (const char*)(ws + B_YD), (size_t)256 * 512, (const char*)(ws + W_DIL), (size_t)256 * 512, 512u, MG, 1024};
              pg8::EpiMerge<false> E{(const bf16_t*)(ws + B_G), MG, 2}; pg8::gemm_phase(lds, tid, 256, 512u, S, E); }
        } break;
        case 6: {
            pg8::SchedSimple S{64, 4, G, wg, (const char*)XB, (size_t)256 * 2048, (const char*)(ws + W_MIX), (size_t)256 * 2048, 2048u, nullptr, 0};
            pg8::EpiRes E{xres, outp};
            pg8::gemm_phase(lds, tid, DM, 2048u, S, E);
        } break;
        case 7: case 13: {
            const float* gam = INP(k == 7 ? 7 : 13) + (size_t)l * DM; const float* bet = INP(k == 7 ? 8 : 14) + (size_t)l * DM;
            for (int m = gw; m < M_TOK; m += NGW) {
                f32x4* xr = (f32x4*)(outp + (size_t)m * DM) + lane;
                f32x4 v[4]; float s = 0.f;
#pragma unroll
                for (int j = 0; j < 4; ++j) { v[j] = xr[64 * j]; s += (v[j][0] + v[j][1]) + (v[j][2] + v[j][3]); }
                const float mean = wave_sum(s) * (1.f / DM); float s2 = 0.f;
#pragma unroll
                for (int j = 0; j < 4; ++j) { v[j] = v[j] - mean; s2 += (v[j][0] * v[j][0] + v[j][1] * v[j][1]) + (v[j][2] * v[j][2] + v[j][3] * v[j][3]); }
                const float rstd = 1.f / sqrtf(wave_sum(s2) * (1.f / DM) + LN_EPS);
                u32x2* o8 = (u32x2*)(XB + (size_t)m * DM) + lane;
#pragma unroll
                for (int j = 0; j < 4; ++j) {
                    const f32x4 gg = *((const f32x4*)gam + lane + 64 * j), bb = *((const f32x4*)bet + lane + 64 * j);
                    const f32x4 y = v[j] * rstd * gg + bb;
                    xr[64 * j] = y;
                    u32x2 o; o.x = cvtpk(y[0], y[1]); o.y = cvtpk(y[2], y[3]); o8[64 * j] = o;
                }
            }
        } break;
        case 8: case 10: {
            const int bb = (k == 10);
            pg8::SchedSimple S{32, 22, G, wg, (const char*)XB + (size_t)bb * SEQ * 2048, (size_t)256 * 2048, (const char*)(ws + W_UP), (size_t)256 * 2048, 2048u, (bf16_t*)(ws + B_U), DFF2};
            pg8::EpiBf16<0> E;
            pg8::gemm_phase(lds, tid, DM, 2048u, S, E);
        } break;
        case 9: case 11: {
            const int bb = (k == 11);
            const bf16_t* U = (const bf16_t*)(ws + B_U); bf16_t* Hh = (bf16_t*)(ws + B_H) + (size_t)bb * SEQ * DFF;
            const float* wf = INP(10) + (size_t)l * 3 * DFF2; const float* bfc = INP(11) + (size_t)l * DFF2;
            for (int it = gt; it < SEQ * 352; it += NGT) {
                const int t = it / 352, c8 = (it % 352) * 8;
                float ga[8], va[8];
                { const f32x4 b0 = *(const f32x4*)(bfc + c8), b1 = *(const f32x4*)(bfc + c8 + 4), d0 = *(const f32x4*)(bfc + DFF + c8), d1 = *(const f32x4*)(bfc + DFF + c8 + 4);
#pragma unroll
                  for (int e = 0; e < 4; ++e) { ga[e] = b0[e]; ga[4 + e] = b1[e]; va[e] = d0[e]; va[4 + e] = d1[e]; } }
#pragma unroll
                for (int j = 0; j < 3; ++j) {
                    if (t >= j) {
                        const u32x4 ug = *(const u32x4*)(U + (size_t)(t - j) * DFF2 + c8), uv = *(const u32x4*)(U + (size_t)(t - j) * DFF2 + DFF + c8);
                        const f32x4 w0 = *(const f32x4*)(wf + j * DFF2 + c8), w1 = *(const f32x4*)(wf + j * DFF2 + c8 + 4);
                        const f32x4 x0 = *(const f32x4*)(wf + j * DFF2 + DFF + c8), x1 = *(const f32x4*)(wf + j * DFF2 + DFF + c8 + 4);
                        ga[0] += w0[0] * bflo(ug.x); ga[1] += w0[1] * bfhi(ug.x); ga[2] += w0[2] * bflo(ug.y); ga[3] += w0[3] * bfhi(ug.y);
                        ga[4] += w1[0] * bflo(ug.z); ga[5] += w1[1] * bfhi(ug.z); ga[6] += w1[2] * bflo(ug.w); ga[7] += w1[3] * bfhi(ug.w);
                        va[0] += x0[0] * bflo(uv.x); va[1] += x0[1] * bfhi(uv.x); va[2] += x0[2] * bflo(uv.y); va[3] += x0[3] * bfhi(uv.y);
                        va[4] += x1[0] * bflo(uv.z); va[5] += x1[1] * bfhi(uv.z); va[6] += x1[2] * bflo(uv.w); va[7] += x1[3] * bfhi(uv.w);
                    }
                }
                float hv[8];
#pragma unroll
                for (int e = 0; e < 8; ++e) hv[e] = ga[e] * fast_sigmoid(ga[e]) * va[e];
                u32x4 o; o.x = cvtpk(hv[0], hv[1]); o.y = cvtpk(hv[2], hv[3]); o.z = cvtpk(hv[4], hv[5]); o.w = cvtpk(hv[6], hv[7]);
                *(u32x4*)(Hh + (size_t)t * DFF + c8) = o;
            }
        } break;
        case 12: {
            pg8::SchedSimple S{64, 4, G, wg, (const char*)(ws + B_H), (size_t)256 * DFF * 2, (const char*)(ws + W_DOWN), (size_t)256 * DFF * 2, (unsigned)(DFF * 2), nullptr, 0};
            pg8::EpiRes E{outp, outp};
            pg8::gemm_phase(lds, tid, DFF, (unsigned)(DFF * 2), S, E);
        } break;
        default: break;
        }
        if (ph + 1 < P.ph_hi) {
            if (ph == P.ph_lo) grid.sync();
            else xcd_barrier(xbar);
#ifdef PROBE_SYNC
            for (int rep = 0; rep < PROBE_SYNC; ++rep) xcd_barrier(xbar);
#endif
        }
    }
}

constexpr int LDS_BYTES = 131072 + 1024;

extern "C" void kernel_launch(void* const* d_in, const int* in_sizes, int n_in, void* d_out, int out_size, void* d_ws, size_t ws_size, hipStream_t stream) {
    static int grid = 0;
    if (grid == 0) {
        if (n_in != 15 || out_size != M_TOK * DM || ws_size < WS_NEED) { fprintf(stderr, "kernel_launch: unexpected shapes (n_in %d out %d ws %zu need %zu)\n", n_in, out_size, ws_size, (size_t)WS_NEED); grid = -1; return; }
        int dev = 0, cus = 0, per_cu = 0;
        hipGetDevice(&dev);
        hipDeviceGetAttribute(&cus, hipDeviceAttributeMultiprocessorCount, dev);
        hipFuncSetAttribute((const void*)mega_fwd, hipFuncAttributeMaxDynamicSharedMemorySize, LDS_BYTES);
        hipOccupancyMaxActiveBlocksPerMultiprocessor(&per_cu, (const void*)mega_fwd, 512, LDS_BYTES);
        if (per_cu < 1) { fprintf(stderr, "kernel_launch: occupancy query says %d blocks/CU\n", per_cu); per_cu = 1; }
        grid = cus;
        (void)hipGetLastError();
    }
    if (grid < 0) return;
    if (hipMemsetAsync(d_ws, 0, 16384, stream) != hipSuccess) { fprintf(stderr, "kernel_launch: memset failed\n"); return; }
    Params p{};
    for (int i = 0; i < 15; ++i) p.in[i] = (const float*)d_in[i];
    p.out = (float*)d_out; p.ws = (unsigned char*)d_ws;
#ifndef MK_SPLIT
    p.ph_lo = 0; p.ph_hi = NPH;
    void* args[] = {&p};
    hipError_t e = hipLaunchCooperativeKernel((const void*)mega_fwd, dim3(grid), dim3(512), args, LDS_BYTES, stream);
    if (e != hipSuccess) fprintf(stderr, "cooperative launch failed: %s (grid %d)\n", hipGetErrorString(e), grid);
#else
    for (int ph = 0; ph < NPH; ++ph) {
        p.ph_lo = ph; p.ph_hi = ph + 1;
        void* args[] = {&p};
        hipError_t e = hipLaunchCooperativeKernel((const void*)mega_fwd, dim3(grid), dim3(512), args, LDS_BYTES, stream);
        if (e != hipSuccess) { fprintf(stderr, "launch %d failed: %s\n", ph, hipGetErrorString(e)); break; }
    }
#endif
}
```

```cpp
#include <hip/hip_runtime.h>
#include <hip/hip_cooperative_groups.h>
#include <cstdio>
#include <cstdint>
namespace cg = cooperative_groups;

#define LAS __attribute__((address_space(3)))
#define GAS __attribute__((address_space(1)))
typedef unsigned short bf16_t;
typedef short bf16x8 __attribute__((ext_vector_type(8)));
typedef short s16x4 __attribute__((ext_vector_type(4)));
typedef float f32x4 __attribute__((ext_vector_type(4)));
typedef float f32x16 __attribute__((ext_vector_type(16)));
typedef unsigned u32x4 __attribute__((ext_vector_type(4)));
typedef unsigned u32x2 __attribute__((ext_vector_type(2)));
typedef float f32x2_t __attribute__((ext_vector_type(2)));
typedef __bf16 bf16x2_t __attribute__((ext_vector_type(2)));

constexpr int M_TOK = 16384, SEQ = 8192, DM = 1024, INC = 8448, DFF = 2816, DFF2 = 5632;
constexpr float LN_EPS = 1e-5f;
constexpr float DN_ALPHA = 1.41421356237f;
constexpr int NPH_LAYER = 11, NPH = 2 * NPH_LAYER;

constexpr size_t MiB = 1u << 20;
constexpr size_t W_IN = 1 * MiB;
constexpr size_t W_MOBA = W_IN + (size_t)INC * DM * 2;
constexpr size_t W_CONV = W_MOBA + 1024 * 512 * 2;
constexpr size_t W_DIL = W_CONV + 1024 * 512 * 2;
constexpr size_t W_MIX = W_DIL + 1024 * 256 * 2;
constexpr size_t W_UP = W_MIX + 1024 * 1024 * 2;
constexpr size_t W_DOWN = W_UP + (size_t)DFF2 * DM * 2;
constexpr size_t W_END = W_DOWN + (size_t)DM * DFF * 2;
constexpr size_t WS_XB = W_END;
constexpr size_t WS_KMEAN = WS_XB + 32 * MiB;
constexpr size_t WS_LSE = WS_KMEAN + 131072;
constexpr size_t WS_BIG = WS_KMEAN + 1 * MiB;
constexpr size_t B_QA = WS_BIG, B_BC = B_QA + 16 * MiB, B_QD = B_BC + 16 * MiB, B_YD = B_QD + 24 * MiB, B_KA = B_YD + 8 * MiB,
                 B_VTA = B_KA + 16 * MiB, B_KD = B_VTA + 16 * MiB, B_VTD = B_KD + 24 * MiB, B_CC = B_VTD + 24 * MiB, B_HH = B_CC + 16 * MiB,
                 B_END = B_HH + 16 * MiB;
constexpr size_t B_G = B_KA;
constexpr size_t B_U = WS_BIG;
constexpr size_t B_H = WS_BIG + 88 * MiB;
constexpr size_t WS_NEED = B_END;
static_assert(W_END % 256 == 0 && B_G + 96 * MiB <= B_HH && B_H + 88 * MiB <= B_END, "ws map");

__device__ __forceinline__ unsigned cvtpk(float lo, float hi) { f32x2_t v = {lo, hi}; bf16x2_t b = __builtin_convertvector(v, bf16x2_t); return __builtin_bit_cast(unsigned, b); }
__device__ __forceinline__ float bflo(unsigned w) { return __uint_as_float(w << 16); }
__device__ __forceinline__ float bfhi(unsigned w) { return __uint_as_float(w & 0xffff0000u); }
__device__ __forceinline__ float fast_sigmoid(float x) { return __builtin_amdgcn_rcpf(1.0f + __builtin_amdgcn_exp2f(-1.44269504089f * x)); }

namespace pg8 {
constexpr int BM = 256, BK = 64, HALF = 128, HTB = HALF * BK * 2, STAGE_BYTES = 8 * HTB, NXCD = 8, WGM = 8;
__host__ __device__ __forceinline__ int lds_byte(int r, int c) { const int st = (r >> 4) * 2 + (c >> 5), rr = r & 15, cc = c & 31, ob = rr * 64 + cc * 2; return st * 1024 + (ob ^ (((ob >> 9) & 1) << 5)); }
__host__ __device__ __forceinline__ void stage_rc(int b, int& R, int& C) { const int st = b / 1024, sb = b % 1024, swz = sb ^ (((sb >> 9) & 1) << 5); R = (st >> 1) * 16 + swz / 64; C = (st & 1) * 32 + (swz % 64) / 2; }
__host__ __device__ __forceinline__ int perm32(int rho) { const int n = rho >> 4, i = rho & 15; return 8 * (i >> 2) + 4 * n + (i & 3); }

struct GUnit { const char* A; const char* B; unsigned ldb; bf16_t* O; int ldc; int r0, c0; };

__device__ __forceinline__ void tile_order(int wgid, int nM, int nN, int& pm, int& pn) {
    const int nwg = nM * nN;
    { const int q = nwg / NXCD, r = nwg % NXCD, xcd = wgid % NXCD, off = wgid / NXCD; wgid = (xcd < r ? xcd * (q + 1) : r * (q + 1) + (xcd - r) * q) + off; }
    const int nig = WGM * nN, gid = wgid / nig, fm = gid * WGM, gsz = (nM - fm) < WGM ? (nM - fm) : WGM;
    pm = fm + ((wgid % nig) % gsz); pn = (wgid % nig) / gsz;
}

template <class Sched, class Epi>
__device__ __forceinline__ void gemm_phase(LAS unsigned char* lds, const int tid, const int K, const unsigned lda, const Sched& S, const Epi& E) {
    const int wid = __builtin_amdgcn_readfirstlane(tid >> 6), lane = tid & 63, wr = wid >> 2, wc = wid & 3, fr = lane & 15, fq = lane >> 4;
    const int nt = K / BK;
    unsigned voffA[2], RB[2], CC2[2];
#pragma unroll
    for (int i = 0; i < 2; ++i) { int R, C; stage_rc(tid * 16 + i * 8192, R, C); const int Rb = (R & ~31) + perm32(R & 31);
        voffA[i] = (unsigned)R * lda + (unsigned)C * 2u; RB[i] = (unsigned)Rb; CC2[i] = (unsigned)C * 2u; }
    const size_t kstep = (size_t)(BK * 2);
    const size_t hstepA = (size_t)HALF * lda;
    const unsigned ldsw = (unsigned)wid * 1024u;
    const int aoff = lds_byte(wr * 64 + fr, fq * 8), boff = lds_byte(wc * 32 + fr, fq * 8);
#define PG8_SA(b, h) (((b) * 2 + (h)) * HTB)
#define PG8_SB(b, h) ((4 + (b) * 2 + (h)) * HTB)
#define PG8_STAGE(bufoff, gbase, voff) do { _Pragma("unroll") for (int _i = 0; _i < 2; ++_i) \
        __builtin_amdgcn_global_load_lds((const unsigned*)((const char*)(gbase) + (voff)[_i]), (LAS unsigned*)(lds + (bufoff) + ldsw + _i * 8192), 16, 0, 0); } while (0)
#define PG8_LDA(dst, b, h) do { _Pragma("unroll") for (int m = 0; m < 4; ++m) _Pragma("unroll") for (int k = 0; k < 2; ++k) dst[m][k] = *(const LAS bf16x8*)(lds + PG8_SA(b, h) + aoff + m * 2048 + k * 1024); } while (0)
#define PG8_LDB(dst, b, h) do { _Pragma("unroll") for (int n = 0; n < 2; ++n) _Pragma("unroll") for (int k = 0; k < 2; ++k) dst[n][k] = *(const LAS bf16x8*)(lds + PG8_SB(b, h) + boff + n * 2048 + k * 1024); } while (0)
#define PG8_MMA(ai, bj, At, Bt) do { __builtin_amdgcn_s_setprio(1); _Pragma("unroll") for (int m = 0; m < 4; ++m) _Pragma("unroll") for (int n = 0; n < 2; ++n) _Pragma("unroll") for (int k = 0; k < 2; ++k) \
        acc[ai][bj][m][n] = __builtin_amdgcn_mfma_f32_16x16x32_bf16(Bt[n][k], At[m][k], acc[ai][bj][m][n], 0, 0, 0); __builtin_amdgcn_s_setprio(0); } while (0)
#define PG8_WAIT_V(n) asm volatile("s_waitcnt vmcnt(" #n ")" ::: "memory")
#define PG8_WAIT_L(n) asm volatile("s_waitcnt lgkmcnt(" #n ")" ::: "memory")
#define PG8_BAR __builtin_amdgcn_s_barrier()
#define PG8_SCHED __builtin_amdgcn_sched_barrier(0)
    GUnit cur, nxt; int ui = 0;
    if (!S.next(0, cur)) return;
    f32x4 acc[2][2][4][2];
#pragma unroll
    for (int a = 0; a < 2; ++a)
#pragma unroll
        for (int b = 0; b < 2; ++b)
#pragma unroll
            for (int m = 0; m < 4; ++m)
#pragma unroll
                for (int n = 0; n < 2; ++n) acc[a][b][m][n] = (f32x4){0.f, 0.f, 0.f, 0.f};
    bf16x8 At[4][2], B0[2][2], B1[2][2];
    const char* cA = cur.A; const char* cB = cur.B;
    unsigned vBc[2] = {RB[0] * cur.ldb + CC2[0], RB[1] * cur.ldb + CC2[1]};
    size_t hBc = (size_t)HALF * cur.ldb;
    PG8_STAGE(PG8_SB(0, 0), cB, vBc); PG8_STAGE(PG8_SB(0, 1), cB + hBc, vBc); PG8_STAGE(PG8_SA(0, 0), cA, voffA); PG8_STAGE(PG8_SA(0, 1), cA + hstepA, voffA);
    if (wr == 1) PG8_BAR;
    PG8_WAIT_V(2); PG8_BAR;
    PG8_STAGE(PG8_SB(1, 0), cB + kstep, vBc); PG8_STAGE(PG8_SA(1, 0), cA + kstep, voffA); PG8_STAGE(PG8_SB(1, 1), cB + hBc + kstep, vBc);
    PG8_WAIT_V(6); PG8_BAR;
    for (;;) {
        const bool has_next = S.next(ui + 1, nxt);
        const char* nA = has_next ? nxt.A : cA; const char* nB = has_next ? nxt.B : cB;
        const unsigned nldb = has_next ? nxt.ldb : cur.ldb;
        unsigned vBn[2] = {RB[0] * nldb + CC2[0], RB[1] * nldb + CC2[1]};
        const size_t hBn = (size_t)HALF * nldb;
        for (int t = 0; t < nt; t += 2) {
            const bool last = (t == nt - 2);
            const char* a1 = cA + (size_t)(t + 1) * kstep;
            const char* a2 = last ? nA : cA + (size_t)(t + 2) * kstep; const char* b2 = last ? nB : cB + (size_t)(t + 2) * kstep;
            const char* a3 = a2 + kstep; const char* b3 = b2 + kstep;
            unsigned vB[2] = {last ? vBn[0] : vBc[0], last ? vBn[1] : vBc[1]};
            const size_t hB = last ? hBn : hBc;
            PG8_LDB(B0, 0, 0); PG8_LDB(B1, 0, 1); PG8_SCHED; PG8_LDA(At, 0, 0); PG8_STAGE(PG8_SA(1, 1), a1 + hstepA, voffA);
            PG8_WAIT_V(8); PG8_WAIT_L(0); PG8_BAR; PG8_MMA(0, 0, At, B0); PG8_MMA(0, 1, At, B1); PG8_BAR; PG8_SCHED;
            PG8_LDA(At, 0, 1); PG8_STAGE(PG8_SB(0, 0), b2, vB); PG8_STAGE(PG8_SB(0, 1), b2 + hB, vB); PG8_STAGE(PG8_SA(0, 0), a2, voffA);
            PG8_WAIT_V(8); PG8_WAIT_L(0); PG8_BAR; PG8_MMA(1, 0, At, B0); PG8_MMA(1, 1, At, B1); PG8_BAR; PG8_SCHED;
            PG8_LDB(B0, 1, 0); PG8_LDB(B1, 1, 1); PG8_SCHED; PG8_LDA(At, 1, 0); PG8_STAGE(PG8_SA(0, 1), a2 + hstepA, voffA);
            PG8_WAIT_V(8); PG8_WAIT_L(0); PG8_BAR; PG8_MMA(0, 0, At, B0); PG8_MMA(0, 1, At, B1); PG8_BAR; PG8_SCHED;
            PG8_LDA(At, 1, 1); PG8_STAGE(PG8_SB(1, 0), b3, vB); PG8_STAGE(PG8_SB(1, 1), b3 + hB, vB); PG8_STAGE(PG8_SA(1, 0), a3, voffA);
            PG8_WAIT_V(8); PG8_WAIT_L(0); PG8_BAR; PG8_MMA(1, 0, At, B0); PG8_MMA(1, 1, At, B1); PG8_BAR; PG8_SCHED;
        }
        if (wr == 0) PG8_BAR;
        E(acc, cur, wr, wc, fr, fq);
        if (!has_next) break;
#pragma unroll
        for (int a = 0; a < 2; ++a)
#pragma unroll
            for (int b = 0; b < 2; ++b)
#pragma unroll
                for (int m = 0; m < 4; ++m)
#pragma unroll
                    for (int n = 0; n < 2; ++n) acc[a][b][m][n] = (f32x4){0.f, 0.f, 0.f, 0.f};
        cur = nxt; cA = nA; cB = nB; vBc[0] = vBn[0]; vBc[1] = vBn[1]; hBc = hBn; ++ui;
        if (wr == 1) PG8_BAR;
    }
    PG8_WAIT_V(0);
    PG8_BAR;
#undef PG8_SA
#undef PG8_SB
#undef PG8_STAGE
#undef PG8_LDA
#undef PG8_LDB
#undef PG8_MMA
#undef PG8_WAIT_V
#undef PG8_WAIT_L
#undef PG8_BAR
#undef PG8_SCHED
}

template <int ACT> struct EpiBf16 {
    bool dry;
    __device__ __forceinline__ void operator()(const f32x4 (&acc)[2][2][4][2], const GUnit& u, int wr, int wc, int fr, int fq) const {
        if (dry) return;
#pragma unroll
        for (int ai = 0; ai < 2; ++ai)
#pragma unroll
            for (int m = 0; m < 4; ++m) {
                const int row = u.r0 + ai * HALF + wr * 64 + m * 16 + fr;
                bf16_t* rowp = u.O + (size_t)row * u.ldc + u.c0 + wc * 32 + 8 * fq;
#pragma unroll
                for (int bj = 0; bj < 2; ++bj) {
                    f32x4 v0 = acc[ai][bj][m][0], v1 = acc[ai][bj][m][1];
                    if (ACT == 1) {
#pragma unroll
                        for (int k = 0; k < 4; ++k) { v0[k] = fast_sigmoid(v0[k]); v1[k] = fast_sigmoid(v1[k]); }
                    }
                    u32x4 w; w.x = cvtpk(v0[0], v0[1]); w.y = cvtpk(v0[2], v0[3]); w.z = cvtpk(v1[0], v1[1]); w.w = cvtpk(v1[2], v1[3]);
                    *(u32x4*)(rowp + bj * HALF) = w;
                }
            }
    }
};
template <bool FIRST> struct EpiMerge {
    const bf16_t* G; bf16_t* Mg; int gi; bool dry;
    __device__ __forceinline__ void operator()(const f32x4 (&acc)[2][2][4][2], const GUnit& u, int wr, int wc, int fr, int fq) const {
        if (dry) return;
#pragma unroll
        for (int ai = 0; ai < 2; ++ai)
#pragma unroll
            for (int m = 0; m < 4; ++m) {
                const int row = u.r0 + ai * HALF + wr * 64 + m * 16 + fr;
#pragma unroll
                for (int bj = 0; bj < 2; ++bj) {
                    const int col = u.c0 + bj * HALF + wc * 32 + 8 * fq;
                    const u32x4 g = *(const u32x4*)(G + (size_t)row * 3072 + gi * 1024 + col);
                    bf16_t* mp = Mg + (size_t)row * 1024 + col;
                    u32x4 o = (u32x4){0u, 0u, 0u, 0u};
                    if (!FIRST) o = *(const u32x4*)mp;
                    const f32x4 v0 = acc[ai][bj][m][0], v1 = acc[ai][bj][m][1];
                    u32x4 w;
                    w.x = cvtpk(bflo(g.x) * v0[0] + bflo(o.x), bfhi(g.x) * v0[1] + bfhi(o.x));
                    w.y = cvtpk(bflo(g.y) * v0[2] + bflo(o.y), bfhi(g.y) * v0[3] + bfhi(o.y));
                    w.z = cvtpk(bflo(g.z) * v1[0] + bflo(o.z), bfhi(g.z) * v1[1] + bfhi(o.z));
                    w.w = cvtpk(bflo(g.w) * v1[2] + bflo(o.w), bfhi(g.w) * v1[3] + bfhi(o.w));
                    *(u32x4*)mp = w;
                }
            }
    }
};
struct EpiRes {
    const float* base; float* out; bool dry;
    __device__ __forceinline__ void operator()(const f32x4 (&acc)[2][2][4][2], const GUnit& u, int wr, int wc, int fr, int fq) const {
        if (dry) return;
#pragma unroll
        for (int ai = 0; ai < 2; ++ai)
#pragma unroll
            for (int m = 0; m < 4; ++m) {
                const int row = u.r0 + ai * HALF + wr * 64 + m * 16 + fr;
#pragma unroll
                for (int bj = 0; bj < 2; ++bj) {
                    const size_t off = (size_t)row * 1024 + u.c0 + bj * HALF + wc * 32 + 8 * fq;
                    const f32x4 b0 = *(const f32x4*)(base + off), b1 = *(const f32x4*)(base + off + 4);
                    *(f32x4*)(out + off) = b0 * DN_ALPHA + acc[ai][bj][m][0];
                    *(f32x4*)(out + off + 4) = b1 * DN_ALPHA + acc[ai][bj][m][1];
                }
            }
    }
};

struct SchedSimple {
    int nM, nN, G, c; const char* A; size_t a_tile; const char* B; size_t b_tile; unsigned ldb; bf16_t* O; int ldc;
    __device__ __forceinline__ bool next(int i, GUnit& u) const {
        const long L = (long)i * G + c; if (L >= (long)nM * nN) return false;
        int pm, pn; tile_order((int)L, nM, nN, pm, pn);
        u.A = A + (size_t)pm * a_tile; u.B = B + (size_t)pn * b_tile; u.ldb = ldb; u.O = O; u.ldc = ldc; u.r0 = pm * 256; u.c0 = pn * 256; return true;
    }
};
struct SchedIN {
    int G, c; const char* xb; const char* wt; unsigned char* ws;
    __device__ __forceinline__ bool next(int i, GUnit& u) const {
        const long L = (long)i * G + c; if (L >= 1344) return false;
        if (L < 1024) {
            int pm, pn; tile_order((int)L, 64, 16, pm, pn);
            const int wtile = pn < 4 ? pn : (pn < 10 ? pn + 2 : pn + 5);
            u.A = xb + (size_t)pm * 256 * 2048; u.B = wt + (size_t)wtile * 256 * 2048; u.ldb = 2048; u.r0 = pm * 256;
            size_t sec; int ct, ldc = 512;
            if (wtile < 2) { sec = B_QA; ct = wtile; }
            else if (wtile < 4) { sec = B_KA; ct = wtile - 2; }
            else if (wtile < 9) { sec = B_QD; ct = wtile - 6; ldc = 768; }
            else if (wtile < 12) { sec = B_KD; ct = wtile - 9; ldc = 768; }
            else if (wtile < 17) { sec = B_BC; ct = wtile - 15; }
            else if (wtile < 19) { sec = B_CC; ct = wtile - 17; }
            else { sec = B_HH; ct = wtile - 19; }
            u.O = (bf16_t*)(ws + sec); u.ldc = ldc; u.c0 = ct * 256;
        } else {
            const int v = (int)L - 1024, sub = v >> 6, it = v & 63;
            u.ldc = 16384; u.c0 = it * 256;
            if (sub < 2) {
                u.A = wt + (size_t)(1024 + 256 * sub) * 2048; u.B = xb + (size_t)it * 256 * 2048; u.ldb = 2048; u.O = (bf16_t*)(ws + B_VTA); u.r0 = 256 * sub;
            } else {
                const int g = sub - 2, r = 1 << (2 * g), b = it >> 5, idx = it & 31, per = 32 >> (2 * g), rho = idx / per, p0 = (idx % per) * 256;
                u.A = wt + (size_t)(3072 + 256 * g) * 2048; u.B = xb + (size_t)(b * SEQ + p0 * r + rho) * 2048; u.ldb = 2048u * (unsigned)r;
                u.O = (bf16_t*)(ws + B_VTD); u.r0 = 256 * g;
            }
        }
        return true;
    }
};

struct EpiFfn {
    const float* wf; const float* bfc; bf16_t* H; LAS float* bnd; bool dry;
    __device__ __forceinline__ void operator()(const f32x4 (&acc)[2][2][4][2], const GUnit& u, int wr, int wc, int fr, int fq) const {
        if (dry) return;
        const int lane = fq * 16 + fr;
        const int it = u.ldc;
        const int tmax = SEQ - 254 * it;
        const bool zero_halo = (it == 0) && (wr == 0);
        const int colloc = wc * 32 + 8 * fq;
        if (fr >= 14) {
#pragma unroll
            for (int ai = 0; ai < 2; ++ai)
#pragma unroll
                for (int bj = 0; bj < 2; ++bj)
#pragma unroll
                    for (int n = 0; n < 2; ++n)
                        *(LAS f32x4*)(bnd + ((ai * 2 + wr) * 2 + (fr - 14)) * 256 + bj * 128 + colloc + 4 * n) = acc[ai][bj][3][n];
        }
        asm volatile("s_waitcnt lgkmcnt(0)" ::: "memory");
        __builtin_amdgcn_s_barrier();
        asm volatile("" ::: "memory");
        const int src1 = (lane & 48) | ((fr + 15) & 15), src2 = (lane & 48) | ((fr + 14) & 15);
#pragma unroll
        for (int n = 0; n < 2; ++n) {
            const int gcol = u.c0 + colloc + 4 * n;
            f32x4 w[2][3], bb[2];
#pragma unroll
            for (int bj = 0; bj < 2; ++bj) {
#pragma unroll
                for (int j = 0; j < 3; ++j) w[bj][j] = *(const f32x4*)(wf + j * DFF2 + bj * DFF + gcol);
                bb[bj] = *(const f32x4*)(bfc + bj * DFF + gcol);
            }
#pragma unroll
            for (int ai = 0; ai < 2; ++ai) {
                const int gidx = ai * 2 + wr;
                f32x4 pr1[2], pr2[2];
#pragma unroll
                for (int bj = 0; bj < 2; ++bj) {
                    if (gidx > 0) {
                        pr1[bj] = *(const LAS f32x4*)(bnd + ((gidx - 1) * 2 + 1) * 256 + bj * 128 + colloc + 4 * n);
                        pr2[bj] = *(const LAS f32x4*)(bnd + ((gidx - 1) * 2 + (fr & 1)) * 256 + bj * 128 + colloc + 4 * n);
                    } else { pr1[bj] = (f32x4){0.f, 0.f, 0.f, 0.f}; pr2[bj] = (f32x4){0.f, 0.f, 0.f, 0.f}; }
                }
#pragma unroll
                for (int m = 0; m < 4; ++m) {
                    f32x4 o[2];
#pragma unroll
                    for (int bj = 0; bj < 2; ++bj) {
                        f32x4 cur = acc[ai][bj][m][n];
                        if (ai == 0 && m == 0) { if (zero_halo && fr < 2) cur = (f32x4){0.f, 0.f, 0.f, 0.f}; }
                        f32x4 c1, c2;
#pragma unroll
                        for (int e = 0; e < 4; ++e) { c1[e] = __shfl(cur[e], src1); c2[e] = __shfl(cur[e], src2); }
                        const f32x4 p1 = (fr >= 1) ? c1 : pr1[bj], p2 = (fr >= 2) ? c2 : pr2[bj];
                        o[bj] = w[bj][0] * cur + w[bj][1] * p1 + w[bj][2] * p2 + bb[bj];
                        pr1[bj] = c1; pr2[bj] = c2;
                    }
                    const int rl = ai * HALF + wr * 64 + m * 16 + fr;
                    if (rl >= 2 && (rl - 2) < tmax) {
                        float hv[4];
#pragma unroll
                        for (int e = 0; e < 4; ++e) hv[e] = o[0][e] * fast_sigmoid(o[0][e]) * o[1][e];
                        u32x2 pk; pk.x = cvtpk(hv[0], hv[1]); pk.y = cvtpk(hv[2], hv[3]);
                        *(u32x2*)(H + (size_t)(u.r0 + rl - 2) * DFF + gcol) = pk;
                    }
                }
            }
        }
    }
};
struct SchedFfn {
    int G, c; const char* xb; const char* wt;
    __device__ __forceinline__ bool next(int i, GUnit& u) const {
        const long L = (long)i * G + c; if (L >= 66 * 22) return false;
        int pm, pn; tile_order((int)L, 66, 22, pm, pn);
        const int b = pm / 33, it = pm % 33;
        u.A = xb + ((long)(b * SEQ + 254 * it) - 2) * 2048; u.B = wt + (size_t)pn * 256 * 2048; u.ldb = 2048; u.O = nullptr; u.ldc = it; u.r0 = b * SEQ + 254 * it; u.c0 = pn * 128;
        return true;
    }
};
}

__device__ __forceinline__ int crow(int r, int hi) { return (r & 3) + 8 * (r >> 2) + 4 * hi; }
struct AttnSt { f32x16 o0, o1; float m, l; };
struct Frags { bf16x8 k[4]; s16x4 v0[4]; s16x4 v1[4]; };

__device__ __forceinline__ void load_frags(Frags& f, const bf16_t* kp, const bf16_t* v0p, const bf16_t* v1p) {
#pragma unroll
    for (int d0 = 0; d0 < 4; ++d0) f.k[d0] = *(const bf16x8*)(kp + 16 * d0);
#pragma unroll
    for (int j = 0; j < 4; ++j) { f.v0[j] = *(const s16x4*)(v0p + 8 * j); f.v1[j] = *(const s16x4*)(v1p + 8 * j); }
}
#define CAT8(a, b) (bf16x8){a[0], a[1], a[2], a[3], b[0], b[1], b[2], b[3]}
__device__ __forceinline__ void attn_step(AttnSt& st, const bf16x8 (&qf)[4], const Frags& f, int kvbase, int hi, int lo_b, int hi_b) {
    f32x16 p;
#pragma unroll
    for (int r = 0; r < 16; ++r) p[r] = 0.f;
#pragma unroll
    for (int d0 = 0; d0 < 4; ++d0) p = __builtin_amdgcn_mfma_f32_32x32x16_bf16(f.k[d0], qf[d0], p, 0, 0, 0);
    const float C2 = 0.125f * 1.44269504089f;
    float mx = -INFINITY;
#pragma unroll
    for (int r = 0; r < 16; ++r) { const int kv = kvbase + crow(r, hi); float s = p[r] * C2; s = (kv >= lo_b && kv <= hi_b) ? s : -INFINITY; p[r] = s; mx = fmaxf(mx, s); }
    mx = fmaxf(mx, __shfl_xor(mx, 32));
    const float mn = fmaxf(st.m, mx);
    const float alpha = __builtin_amdgcn_exp2f(st.m - mn);
    float ps = 0.f;
#pragma unroll
    for (int r = 0; r < 16; ++r) { p[r] = __builtin_amdgcn_exp2f(p[r] - mn); ps += p[r]; }
    st.l = st.l * alpha + ps; st.m = mn;
#pragma unroll
    for (int r = 0; r < 16; ++r) { st.o0[r] *= alpha; st.o1[r] *= alpha; }
    u32x4 wa, wb;
    wa.x = cvtpk(p[0], p[1]); wa.y = cvtpk(p[2], p[3]); wa.z = cvtpk(p[4], p[5]); wa.w = cvtpk(p[6], p[7]);
    wb.x = cvtpk(p[8], p[9]); wb.y = cvtpk(p[10], p[11]); wb.z = cvtpk(p[12], p[13]); wb.w = cvtpk(p[14], p[15]);
    const bf16x8 pa = __builtin_bit_cast(bf16x8, wa), pb = __builtin_bit_cast(bf16x8, wb);
    st.o0 = __builtin_amdgcn_mfma_f32_32x32x16_bf16(CAT8(f.v0[0], f.v0[1]), pa, st.o0, 0, 0, 0);
    st.o0 = __builtin_amdgcn_mfma_f32_32x32x16_bf16(CAT8(f.v0[2], f.v0[3]), pb, st.o0, 0, 0, 0);
    st.o1 = __builtin_amdgcn_mfma_f32_32x32x16_bf16(CAT8(f.v1[0], f.v1[1]), pa, st.o1, 0, 0, 0);
    st.o1 = __builtin_amdgcn_mfma_f32_32x32x16_bf16(CAT8(f.v1[2], f.v1[3]), pb, st.o1, 0, 0, 0);
}
__device__ __forceinline__ void attn_init(AttnSt& st) {
#pragma unroll
    for (int r = 0; r < 16; ++r) { st.o0[r] = 0.f; st.o1[r] = 0.f; }
    st.m = -1e30f; st.l = 0.f;
}
__device__ __forceinline__ float attn_store(const AttnSt& st, bf16_t* orow, int hi, bool dry = false) {
    const float lt = st.l + __shfl_xor(st.l, 32);
    const float inv = 1.0f / lt;
    if (dry && lt > -1.0f) return lt;
#pragma unroll
    for (int g4 = 0; g4 < 4; ++g4) {
        u32x2 a, b;
        a.x = cvtpk(st.o0[4 * g4] * inv, st.o0[4 * g4 + 1] * inv); a.y = cvtpk(st.o0[4 * g4 + 2] * inv, st.o0[4 * g4 + 3] * inv);
        b.x = cvtpk(st.o1[4 * g4] * inv, st.o1[4 * g4 + 1] * inv); b.y = cvtpk(st.o1[4 * g4 + 2] * inv, st.o1[4 * g4 + 3] * inv);
        *(u32x2*)(orow + 8 * g4 + 4 * hi) = a;
        *(u32x2*)(orow + 32 + 8 * g4 + 4 * hi) = b;
    }
    return lt;
}

__device__ __forceinline__ void moba_tile(unsigned char* ws, int b, int h, int qblk, int w, int lane, bool dry = false) {
    const int l31 = lane & 31, hi = lane >> 5;
    const int q = qblk * 256 + w * 32 + l31;
    bf16_t* Qrow = (bf16_t*)(ws + B_QA) + (size_t)(b * SEQ + q) * 512 + h * 64;
    const bf16_t* Kl = (const bf16_t*)(ws + B_KA) + (size_t)(b * SEQ + l31) * 512 + h * 64 + 8 * hi;
    const bf16_t* V0 = (const bf16_t*)(ws + B_VTA) + (size_t)(h * 64 + l31) * 16384 + b * SEQ + 4 * hi;
    const bf16_t* V1 = V0 + (size_t)32 * 16384;
    unsigned mask = 0u;
    if (qblk > 0) {
        float qv[32];
#pragma unroll
        for (int c4 = 0; c4 < 4; ++c4) { const u32x4 t = *(const u32x4*)(Qrow + 32 * hi + 8 * c4);
            qv[8 * c4 + 0] = bflo(t.x); qv[8 * c4 + 1] = bfhi(t.x); qv[8 * c4 + 2] = bflo(t.y); qv[8 * c4 + 3] = bfhi(t.y);
            qv[8 * c4 + 4] = bflo(t.z); qv[8 * c4 + 5] = bfhi(t.z); qv[8 * c4 + 6] = bflo(t.w); qv[8 * c4 + 7] = bfhi(t.w); }
        const float* km = (const float*)(ws + WS_KMEAN) + (size_t)((b * 8 + h) * 32) * 64 + 32 * hi;
        float g[32];
#pragma unroll
        for (int j = 0; j < 32; ++j) {
            float s = 0.f;
            if (j < qblk) {
#pragma unroll
                for (int d4 = 0; d4 < 8; ++d4) { const f32x4 kk = *(const f32x4*)(km + j * 64 + 4 * d4);
                    s += qv[4 * d4] * kk[0] + qv[4 * d4 + 1] * kk[1] + qv[4 * d4 + 2] * kk[2] + qv[4 * d4 + 3] * kk[3]; }
            }
            g[j] = s + __shfl_xor(s, 32);
        }
#pragma unroll
        for (int pass = 0; pass < 3; ++pass) {
            float best = -INFINITY; int bi = -1;
#pragma unroll
            for (int j = 0; j < 32; ++j) { const bool ok = (j < qblk) && !((mask >> j) & 1u) && (g[j] > best); best = ok ? g[j] : best; bi = ok ? j : bi; }
            if (bi >= 0) mask |= 1u << bi;
        }
    }
    unsigned need = 0u;
    for (int j = 0; j < qblk; ++j) if (__any((int)((mask >> j) & 1u))) need |= 1u << j;
    need |= 1u << qblk;
    bf16x8 qf[4];
#pragma unroll
    for (int d0 = 0; d0 < 4; ++d0) qf[d0] = *(const bf16x8*)(Qrow + 16 * d0 + 8 * hi);
    AttnSt st; attn_init(st);
    int blk = __builtin_ctz(need); need &= need - 1u; int i = 0;
    Frags f, fn;
    { const int kv = blk * 256; load_frags(f, Kl + (size_t)kv * 512, V0 + kv, V1 + kv); }
    for (;;) {
        const int nst = (blk == qblk) ? (w + 1) : 8;
        int nblk = blk, ni = i + 1; bool has = true;
        if (ni >= nst) { if (need == 0u) has = false; else { nblk = __builtin_ctz(need); need &= need - 1u; ni = 0; } }
        if (has) { const int kv = nblk * 256 + ni * 32; load_frags(fn, Kl + (size_t)kv * 512, V0 + kv, V1 + kv); }
        const bool own = (blk == qblk);
        const bool sel = own || ((mask >> blk) & 1u);
        const int lo_b = sel ? -1 : 0x7fffffff, hi_b = own ? q : 0x7ffffff0;
        attn_step(st, qf, f, blk * 256 + i * 32, hi, lo_b, hi_b);
        if (!has) break;
        f = fn; blk = nblk; i = ni;
    }
    attn_store(st, Qrow, hi, dry);
}

template <bool DIAG>
__device__ __forceinline__ void attn_step2(AttnSt& st, const bf16x8 (&qf)[4], const Frags& f, int kvbase, int hi, bool sel, int q) {
    f32x16 p;
#pragma unroll
    for (int r = 0; r < 16; ++r) p[r] = 0.f;
#pragma unroll
    for (int d0 = 0; d0 < 4; ++d0) p = __builtin_amdgcn_mfma_f32_32x32x16_bf16(f.k[d0], qf[d0], p, 0, 0, 0);
    const float C2 = 0.125f * 1.44269504089f;
    float mx = -INFINITY;
#pragma unroll
    for (int r = 0; r < 16; ++r) { float s = p[r] * C2; if (DIAG) { const int kv = kvbase + crow(r, hi); s = (kv <= q) ? s : -INFINITY; } p[r] = s; mx = fmaxf(mx, s); }
    if (!DIAG) mx = sel ? mx : -INFINITY;
    mx = fmaxf(mx, __shfl_xor(mx, 32));
    const float mn = fmaxf(st.m, mx);
    const float alpha = __builtin_amdgcn_exp2f(st.m - mn);
    const float mne = (DIAG || sel) ? mn : INFINITY;
    float ps = 0.f;
#pragma unroll
    for (int r = 0; r < 16; ++r) { p[r] = __builtin_amdgcn_exp2f(p[r] - mne); ps += p[r]; }
    st.l = st.l * alpha + ps; st.m = mn;
#pragma unroll
    for (int r = 0; r < 16; ++r) { st.o0[r] *= alpha; st.o1[r] *= alpha; }
    u32x4 wa, wb;
    wa.x = cvtpk(p[0], p[1]); wa.y = cvtpk(p[2], p[3]); wa.z = cvtpk(p[4], p[5]); wa.w = cvtpk(p[6], p[7]);
    wb.x = cvtpk(p[8], p[9]); wb.y = cvtpk(p[10], p[11]); wb.z = cvtpk(p[12], p[13]); wb.w = cvtpk(p[14], p[15]);
    const bf16x8 pa = __builtin_bit_cast(bf16x8, wa), pb = __builtin_bit_cast(bf16x8, wb);
    st.o0 = __builtin_amdgcn_mfma_f32_32x32x16_bf16(CAT8(f.v0[0], f.v0[1]), pa, st.o0, 0, 0, 0);
    st.o0 = __builtin_amdgcn_mfma_f32_32x32x16_bf16(CAT8(f.v0[2], f.v0[3]), pb, st.o0, 0, 0, 0);
    st.o1 = __builtin_amdgcn_mfma_f32_32x32x16_bf16(CAT8(f.v1[0], f.v1[1]), pa, st.o1, 0, 0, 0);
    st.o1 = __builtin_amdgcn_mfma_f32_32x32x16_bf16(CAT8(f.v1[2], f.v1[3]), pb, st.o1, 0, 0, 0);
}
struct TileGen { unsigned rem; int blk, sub; bool valid; };
__device__ __forceinline__ void tg_init(TileGen& g, unsigned need) { g.blk = __builtin_ctz(need); g.rem = need & (need - 1u); g.sub = 0; g.valid = true; }
__device__ __forceinline__ void tg_next(TileGen& g) { if (++g.sub == 4) { g.sub = 0; if (g.rem == 0u) g.valid = false; else { g.blk = __builtin_ctz(g.rem); g.rem &= g.rem - 1u; } } }

__device__ __forceinline__ void moba_unit(unsigned char* ws, LAS unsigned char* lds, volatile LAS unsigned* MISC, int b, int h, int qblk, int w, int lane, int tid) {
    const int l31 = lane & 31, hi = lane >> 5;
    const int q = qblk * 256 + w * 32 + l31;
    bf16_t* Qrow = (bf16_t*)(ws + B_QA) + (size_t)(b * SEQ + q) * 512 + h * 64;
    unsigned mask = 0u;
    if (qblk > 0) {
        float qv[32];
#pragma unroll
        for (int c4 = 0; c4 < 4; ++c4) { const u32x4 t = *(const u32x4*)(Qrow + 32 * hi + 8 * c4);
            qv[8 * c4 + 0] = bflo(t.x); qv[8 * c4 + 1] = bfhi(t.x); qv[8 * c4 + 2] = bflo(t.y); qv[8 * c4 + 3] = bfhi(t.y);
            qv[8 * c4 + 4] = bflo(t.z); qv[8 * c4 + 5] = bfhi(t.z); qv[8 * c4 + 6] = bflo(t.w); qv[8 * c4 + 7] = bfhi(t.w); }
        const float* km = (const float*)(ws + WS_KMEAN) + (size_t)((b * 8 + h) * 32) * 64 + 32 * hi;
        float g[32];
#pragma unroll
        for (int j = 0; j < 32; ++j) {
            float s = 0.f;
            if (j < qblk) {
#pragma unroll
                for (int d4 = 0; d4 < 8; ++d4) { const f32x4 kk = *(const f32x4*)(km + j * 64 + 4 * d4);
                    s += qv[4 * d4] * kk[0] + qv[4 * d4 + 1] * kk[1] + qv[4 * d4 + 2] * kk[2] + qv[4 * d4 + 3] * kk[3]; }
            }
            g[j] = s + __shfl_xor(s, 32);
        }
#pragma unroll
        for (int pass = 0; pass < 3; ++pass) {
            float best = -INFINITY; int bi = -1;
#pragma unroll
            for (int j = 0; j < 32; ++j) { const bool ok = (j < qblk) && !((mask >> j) & 1u) && (g[j] > best); best = ok ? g[j] : best; bi = ok ? j : bi; }
            if (bi >= 0) mask |= 1u << bi;
        }
    }
    unsigned need_w = 0u;
    for (int j = 0; j < qblk; ++j) if (__any((int)((mask >> j) & 1u))) need_w |= 1u << j;
    if (lane == 0) MISC[16 + w] = need_w;
    bf16x8 qf[4];
#pragma unroll
    for (int d0 = 0; d0 < 4; ++d0) qf[d0] = *(const bf16x8*)(Qrow + 16 * d0 + 8 * hi);
    __syncthreads();
    unsigned need = 1u << qblk;
#pragma unroll
    for (int i = 0; i < 8; ++i) need |= MISC[16 + i];
    need = __builtin_amdgcn_readfirstlane(need);
    AttnSt st; attn_init(st);
    const int srow = tid >> 3, sc = tid & 7;
    const bf16_t* gK = (const bf16_t*)(ws + B_KA) + (size_t)(b * SEQ + srow) * 512 + h * 64 + 8 * sc;
    const bf16_t* gV = (const bf16_t*)(ws + B_VTA) + (size_t)(h * 64 + srow) * 16384 + b * SEQ + 8 * sc;
    const int woff = srow * 128 + ((sc ^ (srow & 7)) << 4);
#define MU_ISSUE(g, rk, rv) do { const int kv0_ = (g).blk * 256 + (g).sub * 64; rk = *(const u32x4*)(gK + (size_t)kv0_ * 512); rv = *(const u32x4*)(gV + kv0_); } while (0)
#define MU_WRITE(slot, rk, rv) do { *(LAS u32x4*)(lds + (slot) * 16384 + woff) = rk; *(LAS u32x4*)(lds + (slot) * 16384 + 8192 + woff) = rv; } while (0)
#define MU_COMPUTE(g, slot) do { const int blk_ = (g).blk; const bool own_ = (blk_ == qblk); \
        const bool sel_ = own_ || ((mask >> blk_) & 1u); const bool wn_ = own_ || ((need_w >> blk_) & 1u); \
        _Pragma("unroll") for (int i_ = 0; i_ < 2; ++i_) { const int si_ = (g).sub * 2 + i_; \
            if (wn_ && (!own_ || si_ <= w)) { Frags f_; const int kvr_ = 32 * i_ + l31; \
                _Pragma("unroll") for (int d0 = 0; d0 < 4; ++d0) f_.k[d0] = *(const LAS bf16x8*)(lds + (slot) * 16384 + kvr_ * 128 + (((2 * d0 + hi) ^ (kvr_ & 7)) << 4)); \
                _Pragma("unroll") for (int j_ = 0; j_ < 4; ++j_) { \
                    f_.v0[j_] = *(const LAS s16x4*)(lds + (slot) * 16384 + 8192 + l31 * 128 + (((4 * i_ + j_) ^ (l31 & 7)) << 4) + 8 * hi); \
                    f_.v1[j_] = *(const LAS s16x4*)(lds + (slot) * 16384 + 8192 + (l31 + 32) * 128 + (((4 * i_ + j_) ^ (l31 & 7)) << 4) + 8 * hi); } \
                if (own_ && si_ == w) attn_step2<true>(st, qf, f_, blk_ * 256 + si_ * 32, hi, true, q); \
                else attn_step2<false>(st, qf, f_, blk_ * 256 + si_ * 32, hi, sel_, q); } } } while (0)
    TileGen gi; tg_init(gi, need);
    TileGen gc = gi;
    u32x4 rk0, rv0, rk1, rv1;
    MU_ISSUE(gi, rk0, rv0); tg_next(gi);
    MU_ISSUE(gi, rk1, rv1); tg_next(gi);
    MU_WRITE(0, rk0, rv0);
    __syncthreads();
    for (;;) {
        if (gi.valid) { MU_ISSUE(gi, rk0, rv0); tg_next(gi); }
        MU_COMPUTE(gc, 0); tg_next(gc);
        if (!gc.valid) break;
        MU_WRITE(1, rk1, rv1);
        __syncthreads();
        if (gi.valid) { MU_ISSUE(gi, rk1, rv1); tg_next(gi); }
        MU_COMPUTE(gc, 1); tg_next(gc);
        if (!gc.valid) break;
        MU_WRITE(0, rk0, rv0);
        __syncthreads();
    }
#undef MU_ISSUE
#undef MU_WRITE
#undef MU_COMPUTE
    attn_store(st, Qrow, hi);
    __syncthreads();
}

__device__ __forceinline__ void dil_tile(unsigned char* ws, int tile, int lane, bool dry = false) {
    const int l31 = lane & 31, hi = lane >> 5;
    const int b = tile / 3072, rem = tile % 3072, hd = rem >> 8, t = rem & 255, g = hd >> 2, sh = 2 * g, r = 1 << sh;
    const int len = SEQ >> sh, tpr = len >> 5, rho = t / tpr, p0 = (t % tpr) * 32;
    const int p = p0 + l31, tok = p * r + rho;
    bf16_t* Qrow = (bf16_t*)(ws + B_QD) + (size_t)(b * SEQ + tok) * 768 + hd * 64;
    const bf16_t* Kl = (const bf16_t*)(ws + B_KD) + (size_t)(b * SEQ + rho) * 768 + hd * 64 + 8 * hi;
    const bf16_t* V0 = (const bf16_t*)(ws + B_VTD) + (size_t)(hd * 64 + l31) * 16384 + b * SEQ + rho * len + 4 * hi;
    const bf16_t* V1 = V0 + (size_t)32 * 16384;
    bf16x8 qf[4];
#pragma unroll
    for (int d0 = 0; d0 < 4; ++d0) qf[d0] = *(const bf16x8*)(Qrow + 16 * d0 + 8 * hi);
    AttnSt st; attn_init(st);
    int s = (p0 >= 128) ? 0 : ((128 - p0) >> 5);
    Frags f, fn;
    { const int kv = p0 - 128 + 32 * s; load_frags(f, Kl + (size_t)((kv + l31) * r) * 768, V0 + kv, V1 + kv); }
    for (;;) {
        const bool has = (s + 1) < 5;
        if (has) { const int kv = p0 - 128 + 32 * (s + 1); load_frags(fn, Kl + (size_t)((kv + l31) * r) * 768, V0 + kv, V1 + kv); }
        attn_step(st, qf, f, p0 - 128 + 32 * s, hi, p - 128, p);
        if (!has) break;
        f = fn; ++s;
    }
    const float lt = attn_store(st, Qrow, hi, dry);
    if (hi == 0 && !dry) ((float*)(ws + WS_LSE))[(size_t)(b * SEQ + tok) * 12 + hd] = 0.69314718056f * (st.m + __builtin_amdgcn_logf(lt));
}

__device__ __forceinline__ float wave_sum(float v) {
#pragma unroll
    for (int o = 1; o < 64; o <<= 1) v += __shfl_xor(v, o);
    return v;
}
template <bool PERM_UP = false>
__device__ __forceinline__ void transpose_item(const float* W, int K, int N, bf16_t* WT, LAS float* scr, int item, int lane) {
    const int nblk = N / 32, kb = item / nblk, nb = item % nblk, k0 = 64 * kb, n0 = 32 * nb;
#pragma unroll 8
    for (int i = 0; i < 32; ++i) { const int kk = 2 * i + (lane >> 5); scr[kk * 33 + (lane & 31)] = W[(size_t)(k0 + kk) * N + n0 + (lane & 31)]; }
    asm volatile("s_waitcnt lgkmcnt(0)" ::: "memory");
    const int c = lane & 7;
#pragma unroll
    for (int j = 0; j < 4; ++j) { const int n = (lane >> 3) + 8 * j; const LAS float* s = scr + (8 * c) * 33 + n;
        u32x4 o; o.x = cvtpk(s[0 * 33], s[1 * 33]); o.y = cvtpk(s[2 * 33], s[3 * 33]); o.z = cvtpk(s[4 * 33], s[5 * 33]); o.w = cvtpk(s[6 * 33], s[7 * 33]);
        int nr = n0 + n; if (PERM_UP) { const int hv = nr >= DFF ? 1 : 0, nn = nr - hv * DFF; nr = (nn >> 7) * 256 + hv * 128 + (nn & 127); }
        *(u32x4*)(WT + (size_t)nr * K + k0 + 8 * c) = o; }
    asm volatile("s_waitcnt lgkmcnt(0)" ::: "memory");
}

#define XB_TMO      128
#define XB_XCNT(j)  (256  + 64 * (j))
#define XB_XSUB(j)  (1280 + 64 * (j))
#define XB_XGEN(j)  (2304 + 64 * (j))
#define XB_TOP      3328
#define XB_TOPGEN   3392
#define XCD_BAR_WORDS 3456
#define XB_SPIN_CAP (1u << 22)
__device__ __forceinline__ unsigned xb_ld(unsigned* p)              { return __hip_atomic_load(p, __ATOMIC_RELAXED, __HIP_MEMORY_SCOPE_AGENT); }
__device__ __forceinline__ unsigned xb_add(unsigned* p, unsigned v) { return __hip_atomic_fetch_add(p, v, __ATOMIC_RELAXED, __HIP_MEMORY_SCOPE_AGENT); }
__device__ __forceinline__ unsigned xb_xcc_id() { return (unsigned)__builtin_amdgcn_s_getreg((3 << 11) | 20) & 0xFu; }
#define XB_SPIN(cond, bar) do { unsigned _sp = 0; while (cond) { __builtin_amdgcn_s_sleep(1); \
    if ((++_sp & 255u) == 0u) { if (xb_ld(&(bar)[XB_TMO])) break; if (_sp > XB_SPIN_CAP) { atomicAdd(&(bar)[XB_TMO], 1u); break; } } } } while (0)
struct XcdBarrier { unsigned* bar; unsigned x; volatile LAS unsigned* st; };
__device__ __forceinline__ XcdBarrier xcd_barrier_post(unsigned* bar, volatile LAS unsigned* st) {
    XcdBarrier b; b.bar = bar; b.x = xb_xcc_id(); b.st = st;
    if (threadIdx.x == 0) (void)xb_add(&bar[XB_XCNT(b.x)], 1u);
    return b;
}
__device__ __forceinline__ void xcd_barrier_complete(unsigned* bar, unsigned x, unsigned& nloc, unsigned& nx) {
    const unsigned G = gridDim.x * gridDim.y * gridDim.z;
    unsigned sum, cnt, mine, sp = 0u;
    for (;;) {
        sum = 0u; cnt = 0u; mine = 0u;
#pragma unroll
        for (unsigned j = 0; j < 16; ++j) { const unsigned c = xb_ld(&bar[XB_XCNT(j)]); sum += c; cnt += (c > 0u) ? 1u : 0u; mine = (j == x) ? c : mine; }
        if (sum == G) break;
        __builtin_amdgcn_s_sleep(1);
        if ((++sp & 255u) == 0u) { if (xb_ld(&bar[XB_TMO])) break; if (sp > XB_SPIN_CAP) { atomicAdd(&bar[XB_TMO], 1u); break; } }
    }
    nloc = mine > 0u ? mine : 1u; nx = cnt > 0u ? cnt : 1u;
}
__device__ __forceinline__ void xcd_barrier(const XcdBarrier& b) {
    asm volatile("s_waitcnt vmcnt(0)" ::: "memory");
    __syncthreads();
    if (threadIdx.x == 0) {
        unsigned* bar = b.bar;
        __builtin_amdgcn_s_waitcnt(0);
        unsigned nloc = b.st[0], nx = b.st[1];
        if (nloc == 0u) { xcd_barrier_complete(bar, b.x, nloc, nx); b.st[0] = nloc; b.st[1] = nx; }
        const unsigned old = xb_add(&bar[XB_XSUB(b.x)], 1u);
        const unsigned gen = old / nloc;
        if (old + 1u == (gen + 1u) * nloc) {
            __builtin_amdgcn_fence(__ATOMIC_RELEASE, "agent");
            asm volatile("s_waitcnt vmcnt(0)" ::: "memory");
            const unsigned og = xb_add(&bar[XB_TOP], 1u);
            const unsigned tg = og / nx;
            if (og + 1u == (tg + 1u) * nx) xb_add(&bar[XB_TOPGEN], 1u);
            else XB_SPIN(xb_ld(&bar[XB_TOPGEN]) == tg, bar);
            __builtin_amdgcn_fence(__ATOMIC_ACQUIRE, "agent");
            xb_add(&bar[XB_XGEN(b.x)], 1u);
            asm volatile("s_waitcnt vmcnt(0)" ::: "memory");
        } else {
            XB_SPIN(xb_ld(&bar[XB_XGEN(b.x)]) == gen, bar);
            __builtin_amdgcn_fence(__ATOMIC_ACQUIRE, "agent");
            asm volatile("s_waitcnt vmcnt(0)" ::: "memory");
        }
    }
    __syncthreads();
}

struct Params { const float* in[15]; float* out; unsigned char* ws; int ph_lo, ph_hi; };

__global__ void __launch_bounds__(512, 2) mega_fwd(Params P) {
    extern __shared__ __attribute__((aligned(16))) unsigned char lds_raw[];
    LAS unsigned char* lds = (LAS unsigned char*)lds_raw;
    cg::grid_group grid = cg::this_grid();
    volatile LAS unsigned* MISC = (volatile LAS unsigned*)(lds + 131072);
    if (threadIdx.x < 64) MISC[threadIdx.x] = 0u;
    __syncthreads();
    XcdBarrier xbar = xcd_barrier_post((unsigned*)((GAS unsigned char*)P.ws), MISC + 8);
#if defined(PROBE_GEMM) || defined(PROBE_EW)
    for (int it = 2 * P.ph_lo; it < 2 * P.ph_hi; ++it) {
        const int ph = it >> 1; int dflag = ((it & 1) == 0); asm volatile("" : "+s"(dflag));
#else
    for (int ph = P.ph_lo; ph < P.ph_hi; ++ph) {
        const int dflag = 0;
#endif
        int tid = threadIdx.x; asm volatile("" : "+v"(tid));
        size_t zoff = 0; asm volatile("" : "+s"(zoff));
        unsigned char* ws = (unsigned char*)((GAS unsigned char*)P.ws + zoff);
        float* outp = (float*)((GAS float*)P.out + zoff);
#define INP(i) ((const float*)((const GAS float*)P.in[i] + zoff))
        int G = gridDim.x, wg = blockIdx.x; asm volatile("" : "+s"(G), "+s"(wg));
        const int lane = tid & 63, wave = __builtin_amdgcn_readfirstlane(tid >> 6);
        const int gw = wg * 8 + wave, NGW = G * 8;
        const int gt = wg * 512 + tid, NGT = G * 512;
        bf16_t* XB = (bf16_t*)(ws + WS_XB);
        const int l = ph / NPH_LAYER, k = ph % NPH_LAYER;
        const float* xres = (l == 0) ? INP(0) : outp;
#ifdef ONLY
        if (k != ONLY) continue;
#endif
#ifdef SKIPK
        if (k == SKIPK) continue;
#endif
#ifdef SKIPK2
        if (k == SKIPK2) continue;
#endif
        {
#ifdef PROBE_GEMM
        const bool gdry = dflag != 0;
#else
        const bool gdry = false;
#endif
#ifdef PROBE_EW
        const bool edry = dflag != 0;
#else
        const bool edry = false;
#endif
        if (dflag && !(gdry && (k == 1 || k == 4 || k == 5 || k == 6 || k == 8 || k == 9)) && !(edry && (k == 0 || k == 2 || k == 4 || k == 7 || k == 10))) continue;
        switch (k) {
        case 0: {
            LAS float* scr = (LAS float*)(lds + wave * 16384);
            const int I0 = 16 * 264, I1 = 8 * 32, I2 = 8 * 32, I3 = 4 * 32, I4 = 16 * 32, I5 = 16 * 176, I6 = 44 * 32;
            const int NIT = I0 + I1 + I2 + I3 + I4 + I5 + I6;
            for (int it = gw; it < NIT; it += NGW) {
                int r = it;
                if (r < I0) { transpose_item(INP(1) + (size_t)l * DM * INC, DM, INC, (bf16_t*)(ws + W_IN), scr, r, lane); continue; } r -= I0;
                if (r < I1) { transpose_item(INP(3) + (size_t)l * 512 * DM, 512, DM, (bf16_t*)(ws + W_MOBA), scr, r, lane); continue; } r -= I1;
                if (r < I2) { transpose_item(INP(5) + (size_t)l * 512 * DM, 512, DM, (bf16_t*)(ws + W_CONV), scr, r, lane); continue; } r -= I2;
                if (r < I3) { transpose_item(INP(4) + (size_t)l * 256 * DM, 256, DM, (bf16_t*)(ws + W_DIL), scr, r, lane); continue; } r -= I3;
                if (r < I4) { transpose_item(INP(6) + (size_t)l * DM * DM, DM, DM, (bf16_t*)(ws + W_MIX), scr, r, lane); continue; } r -= I4;
                if (r < I5) { transpose_item<true>(INP(9) + (size_t)l * DM * DFF2, DM, DFF2, (bf16_t*)(ws + W_UP), scr, r, lane); continue; } r -= I5;
                transpose_item(INP(12) + (size_t)l * DFF * DM, DFF, DM, (bf16_t*)(ws + W_DOWN), scr, r, lane);
            }
            if (l == 0) {
                const float* x = INP(0);
                for (int it = gt; it < M_TOK * DM / 8; it += NGT) {
                    const f32x4 a = *(const f32x4*)(x + (size_t)it * 8), c = *(const f32x4*)(x + (size_t)it * 8 + 4);
                    u32x4 o; o.x = cvtpk(a[0], a[1]); o.y = cvtpk(a[2], a[3]); o.z = cvtpk(c[0], c[1]); o.w = cvtpk(c[2], c[3]);
                    *(u32x4*)(XB + (size_t)it * 8) = o;
                }
            }
        } break;
        case 1: {
            pg8::SchedIN S{G, wg, (const char*)XB, (const char*)(ws + W_IN), ws};
            pg8::EpiBf16<0> E{gdry};
            pg8::gemm_phase(lds, tid, DM, 2048u, S, E);
        } break;
        case 2: {
            {
                LAS float* red = (LAS float*)lds;
                const bf16_t* KA = (const bf16_t*)(ws + B_KA);
                for (int it = wg; it < 256; it += G) {
                    const int b = it >> 7, j = (it >> 2) & 31, cgp = it & 3;
                    const int col = cgp * 128 + (tid & 127), rp = tid >> 7;
                    const bf16_t* src = KA + (size_t)(b * SEQ + j * 256 + rp * 64) * 512 + col;
                    float s = 0.f;
                    for (int rr = 0; rr < 64; ++rr) s += __uint_as_float((unsigned)src[(size_t)rr * 512] << 16);
                    __syncthreads();
                    red[tid] = s;
                    __syncthreads();
                    if (tid < 128) {
                        const float tot = (red[tid] + red[tid + 128]) + (red[tid + 256] + red[tid + 384]);
                        const int hh = col >> 6, d = col & 63;
                        ((float*)(ws + WS_KMEAN))[(size_t)((b * 8 + hh) * 32 + j) * 64 + d] = tot * (1.0f / 256.0f);
                    }
                }
            }
            {
                bf16_t* BC = (bf16_t*)(ws + B_BC); const bf16_t* CCp = (const bf16_t*)(ws + B_CC); const bf16_t* HHp = (const bf16_t*)(ws + B_HH);
                const float* wsc = INP(2) + (size_t)l * 3 * 512;
                for (int it = gt; it < M_TOK * 64; it += NGT) {
                    const int row = it >> 6, c8 = (it & 63) * 8, tpos = row & (SEQ - 1);
                    float accv[8];
#pragma unroll
                    for (int e = 0; e < 8; ++e) accv[e] = 0.f;
#pragma unroll
                    for (int j = 0; j < 3; ++j) {
                        if (tpos >= j) {
                            const u32x4 cv = *(const u32x4*)(CCp + (size_t)(row - j) * 512 + c8), hv = *(const u32x4*)(HHp + (size_t)(row - j) * 512 + c8);
                            const f32x4 w0 = *(const f32x4*)(wsc + j * 512 + c8), w1 = *(const f32x4*)(wsc + j * 512 + c8 + 4);
                            accv[0] += w0[0] * bflo(cv.x) * bflo(hv.x); accv[1] += w0[1] * bfhi(cv.x) * bfhi(hv.x);
                            accv[2] += w0[2] * bflo(cv.y) * bflo(hv.y); accv[3] += w0[3] * bfhi(cv.y) * bfhi(hv.y);
                            accv[4] += w1[0] * bflo(cv.z) * bflo(hv.z); accv[5] += w1[1] * bfhi(cv.z) * bfhi(hv.z);
                            accv[6] += w1[2] * bflo(cv.w) * bflo(hv.w); accv[7] += w1[3] * bfhi(cv.w) * bfhi(hv.w);
                        }
                    }
                    const u32x4 bv = *(const u32x4*)(BC + (size_t)row * 512 + c8);
                    u32x4 o;
                    o.x = cvtpk(bflo(bv.x) * accv[0], bfhi(bv.x) * accv[1]); o.y = cvtpk(bflo(bv.y) * accv[2], bfhi(bv.y) * accv[3]);
                    o.z = cvtpk(bflo(bv.z) * accv[4], bfhi(bv.z) * accv[5]); o.w = cvtpk(bflo(bv.w) * accv[6], bfhi(bv.w) * accv[7]);
                    if (!edry || accv[0] == 1.2345e33f) *(u32x4*)(BC + (size_t)row * 512 + c8) = o;
                }
            }
        } break;
        case 3: {
            const int vcu = (G % 8 == 0) ? (wg % 8) * (G / 8) + wg / 8 : wg;
            for (int uidx = vcu; uidx < 256; uidx += G) {
                const int bh = uidx >> 4, s = uidx & 15;
                moba_unit(ws, lds, MISC, bh >> 3, bh & 7, s, wave, lane, tid);
                moba_unit(ws, lds, MISC, bh >> 3, bh & 7, 31 - s, wave, lane, tid);
            }
            { const int per = (6144 + NGW - 1) / NGW, t0 = (vcu * 8 + wave) * per;
              for (int t = t0; t < t0 + per && t < 6144; ++t) dil_tile(ws, t, lane); }
        } break;
        case 4: {
            if (!(dflag && !edry)) {
                const bf16_t* QD = (const bf16_t*)(ws + B_QD); const float* LSE = (const float*)(ws + WS_LSE); bf16_t* YD = (bf16_t*)(ws + B_YD);
                for (int it = gt; it < M_TOK * 32; it += NGT) {
                    const int row = it >> 5, hh = (it >> 3) & 3, d8 = (it & 7) * 8;
                    const float l0 = LSE[(size_t)row * 12 + hh], l1 = LSE[(size_t)row * 12 + 4 + hh], l2 = LSE[(size_t)row * 12 + 8 + hh];
                    const float mx = fmaxf(l0, fmaxf(l1, l2));
                    float e0 = __expf(l0 - mx), e1 = __expf(l1 - mx), e2 = __expf(l2 - mx);
                    const float inv = 1.0f / (e0 + e1 + e2); e0 *= inv; e1 *= inv; e2 *= inv;
                    const u32x4 a = *(const u32x4*)(QD + (size_t)row * 768 + hh * 64 + d8), bq = *(const u32x4*)(QD + (size_t)row * 768 + 256 + hh * 64 + d8),
                                c = *(const u32x4*)(QD + (size_t)row * 768 + 512 + hh * 64 + d8);
                    u32x4 o;
                    o.x = cvtpk(e0 * bflo(a.x) + e1 * bflo(bq.x) + e2 * bflo(c.x), e0 * bfhi(a.x) + e1 * bfhi(bq.x) + e2 * bfhi(c.x));
                    o.y = cvtpk(e0 * bflo(a.y) + e1 * bflo(bq.y) + e2 * bflo(c.y), e0 * bfhi(a.y) + e1 * bfhi(bq.y) + e2 * bfhi(c.y));
                    o.z = cvtpk(e0 * bflo(a.z) + e1 * bflo(bq.z) + e2 * bflo(c.z), e0 * bfhi(a.z) + e1 * bfhi(bq.z) + e2 * bfhi(c.z));
                    o.w = cvtpk(e0 * bflo(a.w) + e1 * bflo(bq.w) + e2 * bflo(c.w), e0 * bfhi(a.w) + e1 * bfhi(bq.w) + e2 * bfhi(c.w));
                    *(u32x4*)(YD + (size_t)row * 256 + hh * 64 + d8) = o;
                }
            }
            pg8::SchedSimple S{64, 12, G, wg, (const char*)XB, (size_t)256 * 2048, (const char*)(ws + W_IN) + (size_t)5376 * 2048, (size_t)256 * 2048, 2048u, (bf16_t*)(ws + B_G), 3072};
            pg8::EpiBf16<1> E{gdry};
            if (!(dflag && !gdry)) pg8::gemm_phase(lds, tid, DM, 2048u, S, E);
        } break;
        case 5: {
            bf16_t* MG = XB;
            { pg8::SchedSimple S{64, 4, G, wg, (const char*)(ws + B_QA), (size_t)256 * 1024, (const char*)(ws + W_MOBA), (size_t)256 * 1024, 1024u, MG, 1024};
              pg8::EpiMerge<true> E{(const bf16_t*)(ws + B_G), MG, 0, gdry}; pg8::gemm_phase(lds, tid, 512, 1024u, S, E); }
            { pg8::SchedSimple S{64, 4, G, wg, (const char*)(ws + B_BC), (size_t)256 * 1024, (const char*)(ws + W_CONV), (size_t)256 * 1024, 1024u, MG, 1024};
              pg8::EpiMerge<false> E{(const bf16_t*)(ws + B_G), MG, 1, gdry}; pg8::gemm_phase(lds, tid, 512, 1024u, S, E); }
            { pg8::SchedSimple S{64, 4, G, wg, (const char*)(ws + B_YD), (size_t)256 * 512, (const char*)(ws + W_DIL), (size_t)256 * 512, 512u, MG, 1024};
              pg8::EpiMerge<false> E{(const bf16_t*)(ws + B_G), MG, 2, gdry}; pg8::gemm_phase(lds, tid, 256, 512u, S, E); }
        } break;
        case 6: {
            pg8::SchedSimple S{64, 4, G, wg, (const char*)XB, (size_t)256 * 2048, (const char*)(ws + W_MIX), (size_t)256 * 2048, 2048u, nullptr, 0};
            pg8::EpiRes E{xres, outp, gdry};
            pg8::gemm_phase(lds, tid, DM, 2048u, S, E);
        } break;
        case 7: case 10: {
            const float* gam = INP(k == 7 ? 7 : 13) + (size_t)l * DM; const float* bet = INP(k == 7 ? 8 : 14) + (size_t)l * DM;
            for (int m = gw; m < M_TOK; m += NGW) {
                f32x4* xr = (f32x4*)(outp + (size_t)m * DM) + lane;
                f32x4 v[4]; float s = 0.f;
#pragma unroll
                for (int j = 0; j < 4; ++j) { v[j] = xr[64 * j]; s += (v[j][0] + v[j][1]) + (v[j][2] + v[j][3]); }
                const float mean = wave_sum(s) * (1.f / DM); float s2 = 0.f;
#pragma unroll
                for (int j = 0; j < 4; ++j) { v[j] = v[j] - mean; s2 += (v[j][0] * v[j][0] + v[j][1] * v[j][1]) + (v[j][2] * v[j][2] + v[j][3] * v[j][3]); }
                const float rstd = 1.f / sqrtf(wave_sum(s2) * (1.f / DM) + LN_EPS);
                u32x2* o8 = (u32x2*)(XB + (size_t)m * DM) + lane;
#pragma unroll
                for (int j = 0; j < 4; ++j) {
                    const f32x4 gg = *((const f32x4*)gam + lane + 64 * j), bb = *((const f32x4*)bet + lane + 64 * j);
                    const f32x4 y = v[j] * rstd * gg + bb;
                    if (!edry || y[0] == 1.2345e33f) { xr[64 * j] = y;
                    u32x2 o; o.x = cvtpk(y[0], y[1]); o.y = cvtpk(y[2], y[3]); o8[64 * j] = o; }
                }
            }
        } break;
        case 8: {
            pg8::SchedFfn S{G, wg, (const char*)XB, (const char*)(ws + W_UP)};
            pg8::EpiFfn E{INP(10) + (size_t)l * 3 * DFF2, INP(11) + (size_t)l * DFF2, (bf16_t*)(ws + B_H), (LAS float*)(lds + 131072 + 1024), gdry};
            pg8::gemm_phase(lds, tid, DM, 2048u, S, E);
        } break;
        case 9: {
            pg8::SchedSimple S{64, 4, G, wg, (const char*)(ws + B_H), (size_t)256 * DFF * 2, (const char*)(ws + W_DOWN), (size_t)256 * DFF * 2, (unsigned)(DFF * 2), nullptr, 0};
            pg8::EpiRes E{outp, outp, gdry};
            pg8::gemm_phase(lds, tid, DFF, (unsigned)(DFF * 2), S, E);
        } break;
        default: break;
        }
        }
        if (ph + 1 < P.ph_hi) {
            if (ph == P.ph_lo) grid.sync();
            else xcd_barrier(xbar);
#ifdef PROBE_SYNC
            for (int rep = 0; rep < PROBE_SYNC; ++rep) xcd_barrier(xbar);
#endif
        }
    }
}

constexpr int LDS_BYTES = 131072 + 1024 + 8192;

extern "C" void kernel_launch(void* const* d_in, const int* in_sizes, int n_in, void* d_out, int out_size, void* d_ws, size_t ws_size, hipStream_t stream) {
    static int grid = 0;
    if (grid == 0) {
        if (n_in != 15 || out_size != M_TOK * DM || ws_size < WS_NEED) { fprintf(stderr, "kernel_launch: unexpected shapes (n_in %d out %d ws %zu need %zu)\n", n_in, out_size, ws_size, (size_t)WS_NEED); grid = -1; return; }
        int dev = 0, cus = 0, per_cu = 0;
        hipGetDevice(&dev);
        hipDeviceGetAttribute(&cus, hipDeviceAttributeMultiprocessorCount, dev);
        hipFuncSetAttribute((const void*)mega_fwd, hipFuncAttributeMaxDynamicSharedMemorySize, LDS_BYTES);
        hipOccupancyMaxActiveBlocksPerMultiprocessor(&per_cu, (const void*)mega_fwd, 512, LDS_BYTES);
        if (per_cu < 1) { fprintf(stderr, "kernel_launch: occupancy query says %d blocks/CU\n", per_cu); per_cu = 1; }
        grid = cus;
        (void)hipGetLastError();
    }
    if (grid < 0) return;
    if (hipMemsetAsync(d_ws, 0, 16384, stream) != hipSuccess) { fprintf(stderr, "kernel_launch: memset failed\n"); return; }
    Params p{};
    for (int i = 0; i < 15; ++i) p.in[i] = (const float*)d_in[i];
    p.out = (float*)d_out; p.ws = (unsigned char*)d_ws;
#ifndef MK_SPLIT
    p.ph_lo = 0; p.ph_hi = NPH;
    void* args[] = {&p};
    hipError_t e = hipLaunchCooperativeKernel((const void*)mega_fwd, dim3(grid), dim3(512), args, LDS_BYTES, stream);
    if (e != hipSuccess) fprintf(stderr, "cooperative launch failed: %s (grid %d)\n", hipGetErrorString(e), grid);
#else
    for (int ph = 0; ph < NPH; ++ph) {
        p.ph_lo = ph; p.ph_hi = ph + 1;
        void* args[] = {&p};
        hipError_t e = hipLaunchCooperativeKernel((const void*)mega_fwd, dim3(grid), dim3(512), args, LDS_BYTES, stream);
        if (e != hipSuccess) { fprintf(stderr, "launch %d failed: %s\n", ph, hipGetErrorString(e)); break; }
    }
#endif
}
```

```cpp
#include <hip/hip_runtime.h>
#include <hip/hip_cooperative_groups.h>
#include <cstdio>
#include <cstdint>
namespace cg = cooperative_groups;

#define LAS __attribute__((address_space(3)))
#define GAS __attribute__((address_space(1)))
typedef unsigned short bf16_t;
typedef short bf16x8 __attribute__((ext_vector_type(8)));
typedef short s16x4 __attribute__((ext_vector_type(4)));
typedef float f32x4 __attribute__((ext_vector_type(4)));
typedef float f32x16 __attribute__((ext_vector_type(16)));
typedef unsigned u32x4 __attribute__((ext_vector_type(4)));
typedef unsigned u32x2 __attribute__((ext_vector_type(2)));
typedef float f32x2_t __attribute__((ext_vector_type(2)));
typedef __bf16 bf16x2_t __attribute__((ext_vector_type(2)));

constexpr int M_TOK = 16384, SEQ = 8192, DM = 1024, INC = 8448, DFF = 2816, DFF2 = 5632;
constexpr float LN_EPS = 1e-5f;
constexpr float DN_ALPHA = 1.41421356237f;
constexpr int NPH_LAYER = 11, NPH = 2 * NPH_LAYER;

constexpr size_t MiB = 1u << 20;
constexpr size_t W_IN = 1 * MiB;
constexpr size_t W_MOBA = W_IN + (size_t)INC * DM * 2;
constexpr size_t W_CONV = W_MOBA + 1024 * 512 * 2;
constexpr size_t W_DIL = W_CONV + 1024 * 512 * 2;
constexpr size_t W_MIX = W_DIL + 1024 * 256 * 2;
constexpr size_t W_UP = W_MIX + 1024 * 1024 * 2;
constexpr size_t W_DOWN = W_UP + (size_t)DFF2 * DM * 2;
constexpr size_t W_END = W_DOWN + (size_t)DM * DFF * 2;
constexpr size_t WS_XB = W_END;
constexpr size_t WS_KMEAN = WS_XB + 32 * MiB;
constexpr size_t WS_LSE = WS_KMEAN + 131072;
constexpr size_t WS_BIG = WS_KMEAN + 1 * MiB;
constexpr size_t B_QA = WS_BIG, B_BC = B_QA + 16 * MiB, B_QD = B_BC + 16 * MiB, B_YD = B_QD + 24 * MiB, B_KA = B_YD + 8 * MiB,
                 B_VTA = B_KA + 16 * MiB, B_KD = B_VTA + 16 * MiB, B_VTD = B_KD + 24 * MiB, B_CC = B_VTD + 24 * MiB, B_HH = B_CC + 16 * MiB,
                 B_END = B_HH + 16 * MiB;
constexpr size_t B_G = B_KA;
constexpr size_t B_U = WS_BIG;
constexpr size_t B_H = WS_BIG + 88 * MiB;
constexpr size_t WS_NEED = B_END;
static_assert(W_END % 256 == 0 && B_G + 96 * MiB <= B_HH && B_H + 88 * MiB <= B_END, "ws map");

__device__ __forceinline__ unsigned cvtpk(float lo, float hi) { f32x2_t v = {lo, hi}; bf16x2_t b = __builtin_convertvector(v, bf16x2_t); return __builtin_bit_cast(unsigned, b); }
__device__ __forceinline__ float bflo(unsigned w) { return __uint_as_float(w << 16); }
__device__ __forceinline__ float bfhi(unsigned w) { return __uint_as_float(w & 0xffff0000u); }
__device__ __forceinline__ float fast_sigmoid(float x) { return __builtin_amdgcn_rcpf(1.0f + __builtin_amdgcn_exp2f(-1.44269504089f * x)); }

namespace pg8 {
constexpr int BM = 256, BK = 64, HALF = 128, HTB = HALF * BK * 2, STAGE_BYTES = 8 * HTB, NXCD = 8, WGM = 8;
__host__ __device__ __forceinline__ int lds_byte(int r, int c) { const int st = (r >> 4) * 2 + (c >> 5), rr = r & 15, cc = c & 31, ob = rr * 64 + cc * 2; return st * 1024 + (ob ^ (((ob >> 9) & 1) << 5)); }
__host__ __device__ __forceinline__ void stage_rc(int b, int& R, int& C) { const int st = b / 1024, sb = b % 1024, swz = sb ^ (((sb >> 9) & 1) << 5); R = (st >> 1) * 16 + swz / 64; C = (st & 1) * 32 + (swz % 64) / 2; }
__host__ __device__ __forceinline__ int perm32(int rho) { const int n = rho >> 4, i = rho & 15; return 8 * (i >> 2) + 4 * n + (i & 3); }

struct GUnit { const char* A; const char* B; unsigned ldb; bf16_t* O; int ldc; int r0, c0; };

__device__ __forceinline__ void tile_order(int wgid, int nM, int nN, int& pm, int& pn) {
    const int nwg = nM * nN;
    { const int q = nwg / NXCD, r = nwg % NXCD, xcd = wgid % NXCD, off = wgid / NXCD; wgid = (xcd < r ? xcd * (q + 1) : r * (q + 1) + (xcd - r) * q) + off; }
    const int nig = WGM * nN, gid = wgid / nig, fm = gid * WGM, gsz = (nM - fm) < WGM ? (nM - fm) : WGM;
    pm = fm + ((wgid % nig) % gsz); pn = (wgid % nig) / gsz;
}

template <class Sched, class Epi>
__device__ __forceinline__ void gemm_phase(LAS unsigned char* lds, const int tid, const int K, const unsigned lda, const Sched& S, const Epi& E) {
    const int wid = __builtin_amdgcn_readfirstlane(tid >> 6), lane = tid & 63, wr = wid >> 2, wc = wid & 3, fr = lane & 15, fq = lane >> 4;
    const int nt = K / BK;
    unsigned voffA[2], RB[2], CC2[2];
#pragma unroll
    for (int i = 0; i < 2; ++i) { int R, C; stage_rc(tid * 16 + i * 8192, R, C); const int Rb = (R & ~31) + perm32(R & 31);
        voffA[i] = (unsigned)R * lda + (unsigned)C * 2u; RB[i] = (unsigned)Rb; CC2[i] = (unsigned)C * 2u; }
    const size_t kstep = (size_t)(BK * 2);
    const size_t hstepA = (size_t)HALF * lda;
    const unsigned ldsw = (unsigned)wid * 1024u;
    const int aoff = lds_byte(wr * 64 + fr, fq * 8), boff = lds_byte(wc * 32 + fr, fq * 8);
#define PG8_SA(b, h) (((b) * 2 + (h)) * HTB)
#define PG8_SB(b, h) ((4 + (b) * 2 + (h)) * HTB)
#define PG8_STAGE(bufoff, gbase, voff) do { _Pragma("unroll") for (int _i = 0; _i < 2; ++_i) \
        __builtin_amdgcn_global_load_lds((const unsigned*)((const char*)(gbase) + (voff)[_i]), (LAS unsigned*)(lds + (bufoff) + ldsw + _i * 8192), 16, 0, 0); } while (0)
#define PG8_LDA(dst, b, h) do { _Pragma("unroll") for (int m = 0; m < 4; ++m) _Pragma("unroll") for (int k = 0; k < 2; ++k) dst[m][k] = *(const LAS bf16x8*)(lds + PG8_SA(b, h) + aoff + m * 2048 + k * 1024); } while (0)
#define PG8_LDB(dst, b, h) do { _Pragma("unroll") for (int n = 0; n < 2; ++n) _Pragma("unroll") for (int k = 0; k < 2; ++k) dst[n][k] = *(const LAS bf16x8*)(lds + PG8_SB(b, h) + boff + n * 2048 + k * 1024); } while (0)
#define PG8_MMA(ai, bj, At, Bt) do { __builtin_amdgcn_s_setprio(1); _Pragma("unroll") for (int m = 0; m < 4; ++m) _Pragma("unroll") for (int n = 0; n < 2; ++n) _Pragma("unroll") for (int k = 0; k < 2; ++k) \
        acc[ai][bj][m][n] = __builtin_amdgcn_mfma_f32_16x16x32_bf16(Bt[n][k], At[m][k], acc[ai][bj][m][n], 0, 0, 0); __builtin_amdgcn_s_setprio(0); } while (0)
#define PG8_WAIT_V(n) asm volatile("s_waitcnt vmcnt(" #n ")" ::: "memory")
#define PG8_WAIT_L(n) asm volatile("s_waitcnt lgkmcnt(" #n ")" ::: "memory")
#define PG8_BAR __builtin_amdgcn_s_barrier()
#define PG8_SCHED __builtin_amdgcn_sched_barrier(0)
    GUnit cur, nxt; int ui = 0;
    if (!S.next(0, cur)) return;
    f32x4 acc[2][2][4][2];
#pragma unroll
    for (int a = 0; a < 2; ++a)
#pragma unroll
        for (int b = 0; b < 2; ++b)
#pragma unroll
            for (int m = 0; m < 4; ++m)
#pragma unroll
                for (int n = 0; n < 2; ++n) acc[a][b][m][n] = (f32x4){0.f, 0.f, 0.f, 0.f};
    bf16x8 At[4][2], B0[2][2], B1[2][2];
    const char* cA = cur.A; const char* cB = cur.B;
    unsigned vBc[2] = {RB[0] * cur.ldb + CC2[0], RB[1] * cur.ldb + CC2[1]};
    size_t hBc = (size_t)HALF * cur.ldb;
    PG8_STAGE(PG8_SB(0, 0), cB, vBc); PG8_STAGE(PG8_SB(0, 1), cB + hBc, vBc); PG8_STAGE(PG8_SA(0, 0), cA, voffA); PG8_STAGE(PG8_SA(0, 1), cA + hstepA, voffA);
    if (wr == 1) PG8_BAR;
    PG8_WAIT_V(2); PG8_BAR;
    PG8_STAGE(PG8_SB(1, 0), cB + kstep, vBc); PG8_STAGE(PG8_SA(1, 0), cA + kstep, voffA); PG8_STAGE(PG8_SB(1, 1), cB + hBc + kstep, vBc);
    PG8_WAIT_V(6); PG8_BAR;
    for (;;) {
        const bool has_next = S.next(ui + 1, nxt);
        const char* nA = has_next ? nxt.A : cA; const char* nB = has_next ? nxt.B : cB;
        const unsigned nldb = has_next ? nxt.ldb : cur.ldb;
        unsigned vBn[2] = {RB[0] * nldb + CC2[0], RB[1] * nldb + CC2[1]};
        const size_t hBn = (size_t)HALF * nldb;
        for (int t = 0; t < nt; t += 2) {
            const bool last = (t == nt - 2);
            const char* a1 = cA + (size_t)(t + 1) * kstep;
            const char* a2 = last ? nA : cA + (size_t)(t + 2) * kstep; const char* b2 = last ? nB : cB + (size_t)(t + 2) * kstep;
            const char* a3 = a2 + kstep; const char* b3 = b2 + kstep;
            unsigned vB[2] = {last ? vBn[0] : vBc[0], last ? vBn[1] : vBc[1]};
            const size_t hB = last ? hBn : hBc;
            PG8_LDB(B0, 0, 0); PG8_LDB(B1, 0, 1); PG8_SCHED; PG8_LDA(At, 0, 0); PG8_STAGE(PG8_SA(1, 1), a1 + hstepA, voffA);
            PG8_WAIT_V(8); PG8_WAIT_L(0); PG8_BAR; PG8_MMA(0, 0, At, B0); PG8_MMA(0, 1, At, B1); PG8_BAR; PG8_SCHED;
            PG8_LDA(At, 0, 1); PG8_STAGE(PG8_SB(0, 0), b2, vB); PG8_STAGE(PG8_SB(0, 1), b2 + hB, vB); PG8_STAGE(PG8_SA(0, 0), a2, voffA);
            PG8_WAIT_V(8); PG8_WAIT_L(0); PG8_BAR; PG8_MMA(1, 0, At, B0); PG8_MMA(1, 1, At, B1); PG8_BAR; PG8_SCHED;
            PG8_LDB(B0, 1, 0); PG8_LDB(B1, 1, 1); PG8_SCHED; PG8_LDA(At, 1, 0); PG8_STAGE(PG8_SA(0, 1), a2 + hstepA, voffA);
            PG8_WAIT_V(8); PG8_WAIT_L(0); PG8_BAR; PG8_MMA(0, 0, At, B0); PG8_MMA(0, 1, At, B1); PG8_BAR; PG8_SCHED;
            PG8_LDA(At, 1, 1); PG8_STAGE(PG8_SB(1, 0), b3, vB); PG8_STAGE(PG8_SB(1, 1), b3 + hB, vB); PG8_STAGE(PG8_SA(1, 0), a3, voffA);
            PG8_WAIT_V(8); PG8_WAIT_L(0); PG8_BAR; PG8_MMA(1, 0, At, B0); PG8_MMA(1, 1, At, B1); PG8_BAR; PG8_SCHED;
        }
        if (wr == 0) PG8_BAR;
        E(acc, cur, wr, wc, fr, fq);
        if (!has_next) break;
#pragma unroll
        for (int a = 0; a < 2; ++a)
#pragma unroll
            for (int b = 0; b < 2; ++b)
#pragma unroll
                for (int m = 0; m < 4; ++m)
#pragma unroll
                    for (int n = 0; n < 2; ++n) acc[a][b][m][n] = (f32x4){0.f, 0.f, 0.f, 0.f};
        cur = nxt; cA = nA; cB = nB; vBc[0] = vBn[0]; vBc[1] = vBn[1]; hBc = hBn; ++ui;
        if (wr == 1) PG8_BAR;
    }
    PG8_WAIT_V(0);
    PG8_BAR;
#undef PG8_SA
#undef PG8_SB
#undef PG8_STAGE
#undef PG8_LDA
#undef PG8_LDB
#undef PG8_MMA
#undef PG8_WAIT_V
#undef PG8_WAIT_L
#undef PG8_BAR
#undef PG8_SCHED
}

template <int ACT> struct EpiBf16 {
    bool dry;
    __device__ __forceinline__ void operator()(const f32x4 (&acc)[2][2][4][2], const GUnit& u, int wr, int wc, int fr, int fq) const {
        if (dry) return;
#pragma unroll
        for (int ai = 0; ai < 2; ++ai)
#pragma unroll
            for (int m = 0; m < 4; ++m) {
                const int row = u.r0 + ai * HALF + wr * 64 + m * 16 + fr;
                bf16_t* rowp = u.O + (size_t)row * u.ldc + u.c0 + wc * 32 + 8 * fq;
#pragma unroll
                for (int bj = 0; bj < 2; ++bj) {
                    f32x4 v0 = acc[ai][bj][m][0], v1 = acc[ai][bj][m][1];
                    if (ACT == 1) {
#pragma unroll
                        for (int k = 0; k < 4; ++k) { v0[k] = fast_sigmoid(v0[k]); v1[k] = fast_sigmoid(v1[k]); }
                    }
                    u32x4 w; w.x = cvtpk(v0[0], v0[1]); w.y = cvtpk(v0[2], v0[3]); w.z = cvtpk(v1[0], v1[1]); w.w = cvtpk(v1[2], v1[3]);
                    *(u32x4*)(rowp + bj * HALF) = w;
                }
            }
    }
};
template <bool FIRST> struct EpiMerge {
    const bf16_t* G; bf16_t* Mg; int gi; bool dry;
    __device__ __forceinline__ void operator()(const f32x4 (&acc)[2][2][4][2], const GUnit& u, int wr, int wc, int fr, int fq) const {
        if (dry) return;
#pragma unroll
        for (int ai = 0; ai < 2; ++ai)
#pragma unroll
            for (int m = 0; m < 4; ++m) {
                const int row = u.r0 + ai * HALF + wr * 64 + m * 16 + fr;
#pragma unroll
                for (int bj = 0; bj < 2; ++bj) {
                    const int col = u.c0 + bj * HALF + wc * 32 + 8 * fq;
                    const u32x4 g = *(const u32x4*)(G + (size_t)row * 3072 + gi * 1024 + col);
                    bf16_t* mp = Mg + (size_t)row * 1024 + col;
                    u32x4 o = (u32x4){0u, 0u, 0u, 0u};
                    if (!FIRST) o = *(const u32x4*)mp;
                    const f32x4 v0 = acc[ai][bj][m][0], v1 = acc[ai][bj][m][1];
                    u32x4 w;
                    w.x = cvtpk(bflo(g.x) * v0[0] + bflo(o.x), bfhi(g.x) * v0[1] + bfhi(o.x));
                    w.y = cvtpk(bflo(g.y) * v0[2] + bflo(o.y), bfhi(g.y) * v0[3] + bfhi(o.y));
                    w.z = cvtpk(bflo(g.z) * v1[0] + bflo(o.z), bfhi(g.z) * v1[1] + bfhi(o.z));
                    w.w = cvtpk(bflo(g.w) * v1[2] + bflo(o.w), bfhi(g.w) * v1[3] + bfhi(o.w));
                    *(u32x4*)mp = w;
                }
            }
    }
};
struct EpiRes {
    const float* base; float* out; bool dry;
    __device__ __forceinline__ void operator()(const f32x4 (&acc)[2][2][4][2], const GUnit& u, int wr, int wc, int fr, int fq) const {
        if (dry) return;
#pragma unroll
        for (int ai = 0; ai < 2; ++ai)
#pragma unroll
            for (int m = 0; m < 4; ++m) {
                const int row = u.r0 + ai * HALF + wr * 64 + m * 16 + fr;
#pragma unroll
                for (int bj = 0; bj < 2; ++bj) {
                    const size_t off = (size_t)row * 1024 + u.c0 + bj * HALF + wc * 32 + 8 * fq;
                    const f32x4 b0 = *(const f32x4*)(base + off), b1 = *(const f32x4*)(base + off + 4);
                    *(f32x4*)(out + off) = b0 * DN_ALPHA + acc[ai][bj][m][0];
                    *(f32x4*)(out + off + 4) = b1 * DN_ALPHA + acc[ai][bj][m][1];
                }
            }
    }
};

struct SchedSimple {
    int nM, nN, G, c; const char* A; size_t a_tile; const char* B; size_t b_tile; unsigned ldb; bf16_t* O; int ldc;
    __device__ __forceinline__ bool next(int i, GUnit& u) const {
        const long L = (long)i * G + c; if (L >= (long)nM * nN) return false;
        int pm, pn; tile_order((int)L, nM, nN, pm, pn);
        u.A = A + (size_t)pm * a_tile; u.B = B + (size_t)pn * b_tile; u.ldb = ldb; u.O = O; u.ldc = ldc; u.r0 = pm * 256; u.c0 = pn * 256; return true;
    }
};
struct SchedIN {
    int G, c; const char* xb; const char* wt; unsigned char* ws;
    __device__ __forceinline__ bool next(int i, GUnit& u) const {
        const long L = (long)i * G + c; if (L >= 1344) return false;
        if (L < 1024) {
            int pm, pn; tile_order((int)L, 64, 16, pm, pn);
            const int wtile = pn < 4 ? pn : (pn < 10 ? pn + 2 : pn + 5);
            u.A = xb + (size_t)pm * 256 * 2048; u.B = wt + (size_t)wtile * 256 * 2048; u.ldb = 2048; u.r0 = pm * 256;
            size_t sec; int ct, ldc = 512;
            if (wtile < 2) { sec = B_QA; ct = wtile; }
            else if (wtile < 4) { sec = B_KA; ct = wtile - 2; }
            else if (wtile < 9) { sec = B_QD; ct = wtile - 6; ldc = 768; }
            else if (wtile < 12) { sec = B_KD; ct = wtile - 9; ldc = 768; }
            else if (wtile < 17) { sec = B_BC; ct = wtile - 15; }
            else if (wtile < 19) { sec = B_CC; ct = wtile - 17; }
            else { sec = B_HH; ct = wtile - 19; }
            u.O = (bf16_t*)(ws + sec); u.ldc = ldc; u.c0 = ct * 256;
        } else {
            const int v = (int)L - 1024, sub = v >> 6, it = v & 63;
            u.ldc = 16384; u.c0 = it * 256;
            if (sub < 2) {
                u.A = wt + (size_t)(1024 + 256 * sub) * 2048; u.B = xb + (size_t)it * 256 * 2048; u.ldb = 2048; u.O = (bf16_t*)(ws + B_VTA); u.r0 = 256 * sub;
            } else {
                const int g = sub - 2, r = 1 << (2 * g), b = it >> 5, idx = it & 31, per = 32 >> (2 * g), rho = idx / per, p0 = (idx % per) * 256;
                u.A = wt + (size_t)(3072 + 256 * g) * 2048; u.B = xb + (size_t)(b * SEQ + p0 * r + rho) * 2048; u.ldb = 2048u * (unsigned)r;
                u.O = (bf16_t*)(ws + B_VTD); u.r0 = 256 * g;
            }
        }
        return true;
    }
};

struct EpiFfn {
    const float* wf; const float* bfc; bf16_t* H; LAS float* bnd; bool dry;
    __device__ __forceinline__ void operator()(const f32x4 (&acc)[2][2][4][2], const GUnit& u, int wr, int wc, int fr, int fq) const {
        if (dry) return;
        const int lane = fq * 16 + fr;
        const int it = u.ldc;
        const int tmax = SEQ - 254 * it;
        const bool zero_halo = (it == 0) && (wr == 0);
        const int colloc = wc * 32 + 8 * fq;
        if (fr >= 14) {
#pragma unroll
            for (int ai = 0; ai < 2; ++ai)
#pragma unroll
                for (int bj = 0; bj < 2; ++bj)
#pragma unroll
                    for (int n = 0; n < 2; ++n)
                        *(LAS f32x4*)(bnd + ((ai * 2 + wr) * 2 + (fr - 14)) * 256 + bj * 128 + colloc + 4 * n) = acc[ai][bj][3][n];
        }
        asm volatile("s_waitcnt lgkmcnt(0)" ::: "memory");
        __builtin_amdgcn_s_barrier();
        asm volatile("" ::: "memory");
        const int src1 = (lane & 48) | ((fr + 15) & 15), src2 = (lane & 48) | ((fr + 14) & 15);
#pragma unroll
        for (int n = 0; n < 2; ++n) {
            const int gcol = u.c0 + colloc + 4 * n;
            f32x4 w[2][3], bb[2];
#pragma unroll
            for (int bj = 0; bj < 2; ++bj) {
#pragma unroll
                for (int j = 0; j < 3; ++j) w[bj][j] = *(const f32x4*)(wf + j * DFF2 + bj * DFF + gcol);
                bb[bj] = *(const f32x4*)(bfc + bj * DFF + gcol);
            }
#pragma unroll
            for (int ai = 0; ai < 2; ++ai) {
                const int gidx = ai * 2 + wr;
                f32x4 pr1[2], pr2[2];
#pragma unroll
                for (int bj = 0; bj < 2; ++bj) {
                    if (gidx > 0) {
                        pr1[bj] = *(const LAS f32x4*)(bnd + ((gidx - 1) * 2 + 1) * 256 + bj * 128 + colloc + 4 * n);
                        pr2[bj] = *(const LAS f32x4*)(bnd + ((gidx - 1) * 2 + (fr & 1)) * 256 + bj * 128 + colloc + 4 * n);
                    } else { pr1[bj] = (f32x4){0.f, 0.f, 0.f, 0.f}; pr2[bj] = (f32x4){0.f, 0.f, 0.f, 0.f}; }
                }
#pragma unroll
                for (int m = 0; m < 4; ++m) {
                    f32x4 o[2];
#pragma unroll
                    for (int bj = 0; bj < 2; ++bj) {
                        f32x4 cur = acc[ai][bj][m][n];
                        if (ai == 0 && m == 0) { if (zero_halo && fr < 2) cur = (f32x4){0.f, 0.f, 0.f, 0.f}; }
                        f32x4 c1, c2;
#pragma unroll
                        for (int e = 0; e < 4; ++e) { c1[e] = __shfl(cur[e], src1); c2[e] = __shfl(cur[e], src2); }
                        const f32x4 p1 = (fr >= 1) ? c1 : pr1[bj], p2 = (fr >= 2) ? c2 : pr2[bj];
                        o[bj] = w[bj][0] * cur + w[bj][1] * p1 + w[bj][2] * p2 + bb[bj];
                        pr1[bj] = c1; pr2[bj] = c2;
                    }
                    const int rl = ai * HALF + wr * 64 + m * 16 + fr;
                    if (rl >= 2 && (rl - 2) < tmax) {
                        float hv[4];
#pragma unroll
                        for (int e = 0; e < 4; ++e) hv[e] = o[0][e] * fast_sigmoid(o[0][e]) * o[1][e];
                        u32x2 pk; pk.x = cvtpk(hv[0], hv[1]); pk.y = cvtpk(hv[2], hv[3]);
                        *(u32x2*)(H + (size_t)(u.r0 + rl - 2) * DFF + gcol) = pk;
                    }
                }
            }
        }
    }
};
struct SchedFfn {
    int G, c; const char* xb; const char* wt;
    __device__ __forceinline__ bool next(int i, GUnit& u) const {
        const long L = (long)i * G + c; if (L >= 66 * 22) return false;
        int pm, pn; tile_order((int)L, 66, 22, pm, pn);
        const int b = pm / 33, it = pm % 33;
        u.A = xb + ((long)(b * SEQ + 254 * it) - 2) * 2048; u.B = wt + (size_t)pn * 256 * 2048; u.ldb = 2048; u.O = nullptr; u.ldc = it; u.r0 = b * SEQ + 254 * it; u.c0 = pn * 128;
        return true;
    }
};
}

__device__ __forceinline__ int crow(int r, int hi) { return (r & 3) + 8 * (r >> 2) + 4 * hi; }
struct AttnSt { f32x16 o0, o1; float m, l; };
struct Frags { bf16x8 k[4]; s16x4 v0[4]; s16x4 v1[4]; };

__device__ __forceinline__ void load_frags(Frags& f, const bf16_t* kp, const bf16_t* v0p, const bf16_t* v1p) {
#pragma unroll
    for (int d0 = 0; d0 < 4; ++d0) f.k[d0] = *(const bf16x8*)(kp + 16 * d0);
#pragma unroll
    for (int j = 0; j < 4; ++j) { f.v0[j] = *(const s16x4*)(v0p + 8 * j); f.v1[j] = *(const s16x4*)(v1p + 8 * j); }
}
#define CAT8(a, b) (bf16x8){a[0], a[1], a[2], a[3], b[0], b[1], b[2], b[3]}
__device__ __forceinline__ void attn_step(AttnSt& st, const bf16x8 (&qf)[4], const Frags& f, int kvbase, int hi, int lo_b, int hi_b) {
    f32x16 p;
#pragma unroll
    for (int r = 0; r < 16; ++r) p[r] = 0.f;
#pragma unroll
    for (int d0 = 0; d0 < 4; ++d0) p = __builtin_amdgcn_mfma_f32_32x32x16_bf16(f.k[d0], qf[d0], p, 0, 0, 0);
    const float C2 = 0.125f * 1.44269504089f;
    float mx = -INFINITY;
#pragma unroll
    for (int r = 0; r < 16; ++r) { const int kv = kvbase + crow(r, hi); float s = p[r] * C2; s = (kv >= lo_b && kv <= hi_b) ? s : -INFINITY; p[r] = s; mx = fmaxf(mx, s); }
    mx = fmaxf(mx, __shfl_xor(mx, 32));
    if (__any(mx > st.m + 8.0f)) {
        const float mn = fmaxf(st.m, mx);
        const float alpha = __builtin_amdgcn_exp2f(st.m - mn);
        st.l *= alpha; st.m = mn;
#pragma unroll
        for (int r = 0; r < 16; ++r) { st.o0[r] *= alpha; st.o1[r] *= alpha; }
    }
    float ps = 0.f;
#pragma unroll
    for (int r = 0; r < 16; ++r) { p[r] = __builtin_amdgcn_exp2f(p[r] - st.m); ps += p[r]; }
    st.l += ps;
    u32x4 wa, wb;
    wa.x = cvtpk(p[0], p[1]); wa.y = cvtpk(p[2], p[3]); wa.z = cvtpk(p[4], p[5]); wa.w = cvtpk(p[6], p[7]);
    wb.x = cvtpk(p[8], p[9]); wb.y = cvtpk(p[10], p[11]); wb.z = cvtpk(p[12], p[13]); wb.w = cvtpk(p[14], p[15]);
    const bf16x8 pa = __builtin_bit_cast(bf16x8, wa), pb = __builtin_bit_cast(bf16x8, wb);
    st.o0 = __builtin_amdgcn_mfma_f32_32x32x16_bf16(CAT8(f.v0[0], f.v0[1]), pa, st.o0, 0, 0, 0);
    st.o0 = __builtin_amdgcn_mfma_f32_32x32x16_bf16(CAT8(f.v0[2], f.v0[3]), pb, st.o0, 0, 0, 0);
    st.o1 = __builtin_amdgcn_mfma_f32_32x32x16_bf16(CAT8(f.v1[0], f.v1[1]), pa, st.o1, 0, 0, 0);
    st.o1 = __builtin_amdgcn_mfma_f32_32x32x16_bf16(CAT8(f.v1[2], f.v1[3]), pb, st.o1, 0, 0, 0);
}
__device__ __forceinline__ void attn_init(AttnSt& st) {
#pragma unroll
    for (int r = 0; r < 16; ++r) { st.o0[r] = 0.f; st.o1[r] = 0.f; }
    st.m = -1e30f; st.l = 0.f;
}
__device__ __forceinline__ float attn_store(const AttnSt& st, bf16_t* orow, int hi, bool dry = false) {
    const float lt = st.l + __shfl_xor(st.l, 32);
    const float inv = 1.0f / lt;
    if (dry && lt > -1.0f) return lt;
#pragma unroll
    for (int g4 = 0; g4 < 4; ++g4) {
        u32x2 a, b;
        a.x = cvtpk(st.o0[4 * g4] * inv, st.o0[4 * g4 + 1] * inv); a.y = cvtpk(st.o0[4 * g4 + 2] * inv, st.o0[4 * g4 + 3] * inv);
        b.x = cvtpk(st.o1[4 * g4] * inv, st.o1[4 * g4 + 1] * inv); b.y = cvtpk(st.o1[4 * g4 + 2] * inv, st.o1[4 * g4 + 3] * inv);
        *(u32x2*)(orow + 8 * g4 + 4 * hi) = a;
        *(u32x2*)(orow + 32 + 8 * g4 + 4 * hi) = b;
    }
    return lt;
}

template <bool DIAG>
__device__ __forceinline__ void attn_step2(AttnSt& st, const bf16x8 (&qf)[4], const Frags& f, int kvbase, int hi, bool sel, int q) {
    f32x16 p;
#pragma unroll
    for (int r = 0; r < 16; ++r) p[r] = 0.f;
#pragma unroll
    for (int d0 = 0; d0 < 4; ++d0) p = __builtin_amdgcn_mfma_f32_32x32x16_bf16(f.k[d0], qf[d0], p, 0, 0, 0);
    const float C2 = 0.125f * 1.44269504089f;
    float mx = -INFINITY;
#pragma unroll
    for (int r = 0; r < 16; ++r) { float s = p[r] * C2; if (DIAG) { const int kv = kvbase + crow(r, hi); s = (kv <= q) ? s : -INFINITY; } p[r] = s; mx = fmaxf(mx, s); }
    if (!DIAG) mx = sel ? mx : -INFINITY;
    mx = fmaxf(mx, __shfl_xor(mx, 32));
    if (__any(mx > st.m + 8.0f)) {
        const float mn = fmaxf(st.m, mx);
        const float alpha = __builtin_amdgcn_exp2f(st.m - mn);
        st.l *= alpha; st.m = mn;
#pragma unroll
        for (int r = 0; r < 16; ++r) { st.o0[r] *= alpha; st.o1[r] *= alpha; }
    }
    const float mne = (DIAG || sel) ? st.m : INFINITY;
    float ps = 0.f;
#pragma unroll
    for (int r = 0; r < 16; ++r) { p[r] = __builtin_amdgcn_exp2f(p[r] - mne); ps += p[r]; }
    st.l += ps;
    u32x4 wa, wb;
    wa.x = cvtpk(p[0], p[1]); wa.y = cvtpk(p[2], p[3]); wa.z = cvtpk(p[4], p[5]); wa.w = cvtpk(p[6], p[7]);
    wb.x = cvtpk(p[8], p[9]); wb.y = cvtpk(p[10], p[11]); wb.z = cvtpk(p[12], p[13]); wb.w = cvtpk(p[14], p[15]);
    const bf16x8 pa = __builtin_bit_cast(bf16x8, wa), pb = __builtin_bit_cast(bf16x8, wb);
    st.o0 = __builtin_amdgcn_mfma_f32_32x32x16_bf16(CAT8(f.v0[0], f.v0[1]), pa, st.o0, 0, 0, 0);
    st.o0 = __builtin_amdgcn_mfma_f32_32x32x16_bf16(CAT8(f.v0[2], f.v0[3]), pb, st.o0, 0, 0, 0);
    st.o1 = __builtin_amdgcn_mfma_f32_32x32x16_bf16(CAT8(f.v1[0], f.v1[1]), pa, st.o1, 0, 0, 0);
    st.o1 = __builtin_amdgcn_mfma_f32_32x32x16_bf16(CAT8(f.v1[2], f.v1[3]), pb, st.o1, 0, 0, 0);
}
struct TileGen { unsigned rem; int blk, sub; bool valid; };
__device__ __forceinline__ void tg_init(TileGen& g, unsigned need) { g.blk = __builtin_ctz(need); g.rem = need & (need - 1u); g.sub = 0; g.valid = true; }
__device__ __forceinline__ void tg_next(TileGen& g) { if (++g.sub == 4) { g.sub = 0; if (g.rem == 0u) g.valid = false; else { g.blk = __builtin_ctz(g.rem); g.rem &= g.rem - 1u; } } }

__device__ __forceinline__ void moba_unit(unsigned char* ws, LAS unsigned char* lds, volatile LAS unsigned* MISC, int b, int h, int qblk, int w, int lane, int tid) {
    const int l31 = lane & 31, hi = lane >> 5;
    const int q = qblk * 256 + w * 32 + l31;
    bf16_t* Qrow = (bf16_t*)(ws + B_QA) + (size_t)(b * SEQ + q) * 512 + h * 64;
    unsigned mask = 0u;
    { const f32x4 kmv = *((const f32x4*)((const float*)(ws + WS_KMEAN) + (size_t)((b * 8 + h) * 32) * 64) + tid);
      *((LAS f32x4*)(lds + 36864) + tid) = kmv; }
    __syncthreads();
    if (qblk > 0) {
        float qv[32];
#pragma unroll
        for (int c4 = 0; c4 < 4; ++c4) { const u32x4 t = *(const u32x4*)(Qrow + 32 * hi + 8 * c4);
            qv[8 * c4 + 0] = bflo(t.x); qv[8 * c4 + 1] = bfhi(t.x); qv[8 * c4 + 2] = bflo(t.y); qv[8 * c4 + 3] = bfhi(t.y);
            qv[8 * c4 + 4] = bflo(t.z); qv[8 * c4 + 5] = bfhi(t.z); qv[8 * c4 + 6] = bflo(t.w); qv[8 * c4 + 7] = bfhi(t.w); }
        const LAS float* km = (const LAS float*)(lds + 36864) + 32 * hi;
        float g[32];
#pragma unroll
        for (int j = 0; j < 32; ++j) {
            float s = 0.f;
            if (j < qblk) {
#pragma unroll
                for (int d4 = 0; d4 < 8; ++d4) { const f32x4 kk = *(const LAS f32x4*)(km + j * 64 + 4 * d4);
                    s += qv[4 * d4] * kk[0] + qv[4 * d4 + 1] * kk[1] + qv[4 * d4 + 2] * kk[2] + qv[4 * d4 + 3] * kk[3]; }
            }
            g[j] = s + __shfl_xor(s, 32);
        }
#pragma unroll
        for (int pass = 0; pass < 3; ++pass) {
            float best = -INFINITY; int bi = -1;
#pragma unroll
            for (int j = 0; j < 32; ++j) { const bool ok = (j < qblk) && !((mask >> j) & 1u) && (g[j] > best); best = ok ? g[j] : best; bi = ok ? j : bi; }
            if (bi >= 0) mask |= 1u << bi;
        }
    }
    unsigned need_w = 0u;
    for (int j = 0; j < qblk; ++j) if (__any((int)((mask >> j) & 1u))) need_w |= 1u << j;
    if (lane == 0) MISC[16 + w] = need_w;
    bf16x8 qf[4];
#pragma unroll
    for (int d0 = 0; d0 < 4; ++d0) qf[d0] = *(const bf16x8*)(Qrow + 16 * d0 + 8 * hi);
    __syncthreads();
    unsigned need = 1u << qblk;
#pragma unroll
    for (int i = 0; i < 8; ++i) need |= MISC[16 + i];
    need = __builtin_amdgcn_readfirstlane(need);
    AttnSt st; attn_init(st);
    const int srow = tid >> 3, sc = tid & 7;
    const bf16_t* gK = (const bf16_t*)(ws + B_KA) + (size_t)(b * SEQ + srow) * 512 + h * 64 + 8 * sc;
    const bf16_t* gV = (const bf16_t*)(ws + B_VTA) + (size_t)(h * 64 + srow) * 16384 + b * SEQ + 8 * sc;
    const int woffK = srow * 144 + sc * 16, woffV = 9216 + srow * 136 + sc * 16;
#define MU_ISSUE(g, rk, rv) do { const int kv0_ = (g).blk * 256 + (g).sub * 64; rk = *(const u32x4*)(gK + (size_t)kv0_ * 512); rv = *(const u32x4*)(gV + kv0_); } while (0)
#define MU_WRITE(slot, rk, rv) do { *(LAS u32x4*)(lds + (slot) * 17920 + woffK) = rk; *(LAS u32x2*)(lds + (slot) * 17920 + woffV) = (u32x2){rv.x, rv.y}; *(LAS u32x2*)(lds + (slot) * 17920 + woffV + 8) = (u32x2){rv.z, rv.w}; } while (0)
#define MU_COMPUTE(g, slot) do { const int blk_ = (g).blk; const bool own_ = (blk_ == qblk); \
        const bool sel_ = own_ || ((mask >> blk_) & 1u); const bool wn_ = own_ || ((need_w >> blk_) & 1u); \
        _Pragma("unroll") for (int i_ = 0; i_ < 2; ++i_) { const int si_ = (g).sub * 2 + i_; \
            if (wn_ && (!own_ || si_ <= w)) { Frags f_; const int kvr_ = 32 * i_ + l31; \
                _Pragma("unroll") for (int d0 = 0; d0 < 4; ++d0) f_.k[d0] = *(const LAS bf16x8*)(lds + (slot) * 17920 + kvr_ * 144 + ((2 * d0 + hi) << 4)); \
                _Pragma("unroll") for (int j_ = 0; j_ < 4; ++j_) { \
                    f_.v0[j_] = *(const LAS s16x4*)(lds + (slot) * 17920 + 9216 + l31 * 136 + ((4 * i_ + j_) << 4) + 8 * hi); \
                    f_.v1[j_] = *(const LAS s16x4*)(lds + (slot) * 17920 + 9216 + (l31 + 32) * 136 + ((4 * i_ + j_) << 4) + 8 * hi); } \
                if (own_ && si_ == w) attn_step2<true>(st, qf, f_, blk_ * 256 + si_ * 32, hi, true, q); \
                else attn_step2<false>(st, qf, f_, blk_ * 256 + si_ * 32, hi, sel_, q); } } } while (0)
    TileGen gi; tg_init(gi, need);
    TileGen gc = gi;
    u32x4 rk0, rv0, rk1, rv1;
    MU_ISSUE(gi, rk0, rv0); tg_next(gi);
    MU_ISSUE(gi, rk1, rv1); tg_next(gi);
    MU_WRITE(0, rk0, rv0);
    __syncthreads();
    for (;;) {
        if (gi.valid) { MU_ISSUE(gi, rk0, rv0); tg_next(gi); }
        MU_COMPUTE(gc, 0); tg_next(gc);
        if (!gc.valid) break;
        MU_WRITE(1, rk1, rv1);
        __syncthreads();
        if (gi.valid) { MU_ISSUE(gi, rk1, rv1); tg_next(gi); }
        MU_COMPUTE(gc, 1); tg_next(gc);
        if (!gc.valid) break;
        MU_WRITE(0, rk0, rv0);
        __syncthreads();
    }
#undef MU_ISSUE
#undef MU_WRITE
#undef MU_COMPUTE
    attn_store(st, Qrow, hi);
    __syncthreads();
}

__device__ __forceinline__ void dil_tile(unsigned char* ws, int tile, int lane, bool dry = false) {
    const int l31 = lane & 31, hi = lane >> 5;
    const int b = tile / 3072, rem = tile % 3072, hd = rem >> 8, t = rem & 255, g = hd >> 2, sh = 2 * g, r = 1 << sh;
    const int len = SEQ >> sh, tpr = len >> 5, rho = t / tpr, p0 = (t % tpr) * 32;
    const int p = p0 + l31, tok = p * r + rho;
    bf16_t* Qrow = (bf16_t*)(ws + B_QD) + (size_t)(b * SEQ + tok) * 768 + hd * 64;
    const bf16_t* Kl = (const bf16_t*)(ws + B_KD) + (size_t)(b * SEQ + rho) * 768 + hd * 64 + 8 * hi;
    const bf16_t* V0 = (const bf16_t*)(ws + B_VTD) + (size_t)(hd * 64 + l31) * 16384 + b * SEQ + rho * len + 4 * hi;
    const bf16_t* V1 = V0 + (size_t)32 * 16384;
    bf16x8 qf[4];
#pragma unroll
    for (int d0 = 0; d0 < 4; ++d0) qf[d0] = *(const bf16x8*)(Qrow + 16 * d0 + 8 * hi);
    AttnSt st; attn_init(st);
    int s = (p0 >= 128) ? 0 : ((128 - p0) >> 5);
    Frags f, fn;
    { const int kv = p0 - 128 + 32 * s; load_frags(f, Kl + (size_t)((kv + l31) * r) * 768, V0 + kv, V1 + kv); }
    for (;;) {
        const bool has = (s + 1) < 5;
        if (has) { const int kv = p0 - 128 + 32 * (s + 1); load_frags(fn, Kl + (size_t)((kv + l31) * r) * 768, V0 + kv, V1 + kv); }
        attn_step(st, qf, f, p0 - 128 + 32 * s, hi, p - 128, p);
        if (!has) break;
        f = fn; ++s;
    }
    const float lt = attn_store(st, Qrow, hi, dry);
    if (hi == 0 && !dry) ((float*)(ws + WS_LSE))[(size_t)(b * SEQ + tok) * 12 + hd] = 0.69314718056f * (st.m + __builtin_amdgcn_logf(lt));
}

__device__ __forceinline__ float wave_sum(float v) {
#pragma unroll
    for (int o = 1; o < 64; o <<= 1) v += __shfl_xor(v, o);
    return v;
}
template <bool PERM_UP = false>
__device__ __forceinline__ void transpose_item(const float* W, int K, int N, bf16_t* WT, LAS float* scr, int item, int lane) {
    const int nblk = N / 32, kb = item / nblk, nb = item % nblk, k0 = 64 * kb, n0 = 32 * nb;
#pragma unroll 8
    for (int i = 0; i < 32; ++i) { const int kk = 2 * i + (lane >> 5); scr[kk * 33 + (lane & 31)] = W[(size_t)(k0 + kk) * N + n0 + (lane & 31)]; }
    asm volatile("s_waitcnt lgkmcnt(0)" ::: "memory");
    const int c = lane & 7;
#pragma unroll
    for (int j = 0; j < 4; ++j) { const int n = (lane >> 3) + 8 * j; const LAS float* s = scr + (8 * c) * 33 + n;
        u32x4 o; o.x = cvtpk(s[0 * 33], s[1 * 33]); o.y = cvtpk(s[2 * 33], s[3 * 33]); o.z = cvtpk(s[4 * 33], s[5 * 33]); o.w = cvtpk(s[6 * 33], s[7 * 33]);
        int nr = n0 + n; if (PERM_UP) { const int hv = nr >= DFF ? 1 : 0, nn = nr - hv * DFF; nr = (nn >> 7) * 256 + hv * 128 + (nn & 127); }
        *(u32x4*)(WT + (size_t)nr * K + k0 + 8 * c) = o; }
    asm volatile("s_waitcnt lgkmcnt(0)" ::: "memory");
}

#define XB_TMO      128
#define XB_XCNT(j)  (256  + 64 * (j))
#define XB_XSUB(j)  (1280 + 64 * (j))
#define XB_XGEN(j)  (2304 + 64 * (j))
#define XB_TOP      3328
#define XB_TOPGEN   3392
#define XCD_BAR_WORDS 3456
#define XB_SPIN_CAP (1u << 22)
__device__ __forceinline__ unsigned xb_ld(unsigned* p)              { return __hip_atomic_load(p, __ATOMIC_RELAXED, __HIP_MEMORY_SCOPE_AGENT); }
__device__ __forceinline__ unsigned xb_add(unsigned* p, unsigned v) { return __hip_atomic_fetch_add(p, v, __ATOMIC_RELAXED, __HIP_MEMORY_SCOPE_AGENT); }
__device__ __forceinline__ unsigned xb_xcc_id() { return (unsigned)__builtin_amdgcn_s_getreg((3 << 11) | 20) & 0xFu; }
#define XB_SPIN(cond, bar) do { unsigned _sp = 0; while (cond) { __builtin_amdgcn_s_sleep(1); \
    if ((++_sp & 255u) == 0u) { if (xb_ld(&(bar)[XB_TMO])) break; if (_sp > XB_SPIN_CAP) { atomicAdd(&(bar)[XB_TMO], 1u); break; } } } } while (0)
struct XcdBarrier { unsigned* bar; unsigned x; volatile LAS unsigned* st; };
__device__ __forceinline__ XcdBarrier xcd_barrier_post(unsigned* bar, volatile LAS unsigned* st) {
    XcdBarrier b; b.bar = bar; b.x = xb_xcc_id(); b.st = st;
    if (threadIdx.x == 0) (void)xb_add(&bar[XB_XCNT(b.x)], 1u);
    return b;
}
__device__ __forceinline__ void xcd_barrier_complete(unsigned* bar, unsigned x, unsigned& nloc, unsigned& nx) {
    const unsigned G = gridDim.x * gridDim.y * gridDim.z;
    unsigned sum, cnt, mine, sp = 0u;
    for (;;) {
        sum = 0u; cnt = 0u; mine = 0u;
#pragma unroll
        for (unsigned j = 0; j < 16; ++j) { const unsigned c = xb_ld(&bar[XB_XCNT(j)]); sum += c; cnt += (c > 0u) ? 1u : 0u; mine = (j == x) ? c : mine; }
        if (sum == G) break;
        __builtin_amdgcn_s_sleep(1);
        if ((++sp & 255u) == 0u) { if (xb_ld(&bar[XB_TMO])) break; if (sp > XB_SPIN_CAP) { atomicAdd(&bar[XB_TMO], 1u); break; } }
    }
    nloc = mine > 0u ? mine : 1u; nx = cnt > 0u ? cnt : 1u;
}
__device__ __forceinline__ void xcd_barrier(const XcdBarrier& b) {
    asm volatile("s_waitcnt vmcnt(0)" ::: "memory");
    __syncthreads();
    if (threadIdx.x == 0) {
        unsigned* bar = b.bar;
        __builtin_amdgcn_s_waitcnt(0);
        unsigned nloc = b.st[0], nx = b.st[1];
        if (nloc == 0u) { xcd_barrier_complete(bar, b.x, nloc, nx); b.st[0] = nloc; b.st[1] = nx; }
        const unsigned old = xb_add(&bar[XB_XSUB(b.x)], 1u);
        const unsigned gen = old / nloc;
        if (old + 1u == (gen + 1u) * nloc) {
            __builtin_amdgcn_fence(__ATOMIC_RELEASE, "agent");
            asm volatile("s_waitcnt vmcnt(0)" ::: "memory");
            const unsigned og = xb_add(&bar[XB_TOP], 1u);
            const unsigned tg = og / nx;
            if (og + 1u == (tg + 1u) * nx) xb_add(&bar[XB_TOPGEN], 1u);
            else XB_SPIN(xb_ld(&bar[XB_TOPGEN]) == tg, bar);
            __builtin_amdgcn_fence(__ATOMIC_ACQUIRE, "agent");
            xb_add(&bar[XB_XGEN(b.x)], 1u);
            asm volatile("s_waitcnt vmcnt(0)" ::: "memory");
        } else {
            XB_SPIN(xb_ld(&bar[XB_XGEN(b.x)]) == gen, bar);
            __builtin_amdgcn_fence(__ATOMIC_ACQUIRE, "agent");
            asm volatile("s_waitcnt vmcnt(0)" ::: "memory");
        }
    }
    __syncthreads();
}

struct Params { const float* in[15]; float* out; unsigned char* ws; int ph_lo, ph_hi; };

__global__ void __launch_bounds__(512, 2) mega_fwd(Params P) {
    extern __shared__ __attribute__((aligned(16))) unsigned char lds_raw[];
    LAS unsigned char* lds = (LAS unsigned char*)lds_raw;
    cg::grid_group grid = cg::this_grid();
    volatile LAS unsigned* MISC = (volatile LAS unsigned*)(lds + 131072);
    if (threadIdx.x < 64) MISC[threadIdx.x] = 0u;
    __syncthreads();
    XcdBarrier xbar = xcd_barrier_post((unsigned*)((GAS unsigned char*)P.ws), MISC + 8);
#if defined(PROBE_GEMM) || defined(PROBE_EW)
    for (int it = 2 * P.ph_lo; it < 2 * P.ph_hi; ++it) {
        const int ph = it >> 1; int dflag = ((it & 1) == 0); asm volatile("" : "+s"(dflag));
#else
    for (int ph = P.ph_lo; ph < P.ph_hi; ++ph) {
        const int dflag = 0;
#endif
        int tid = threadIdx.x; asm volatile("" : "+v"(tid));
        size_t zoff = 0; asm volatile("" : "+s"(zoff));
        unsigned char* ws = (unsigned char*)((GAS unsigned char*)P.ws + zoff);
        float* outp = (float*)((GAS float*)P.out + zoff);
#define INP(i) ((const float*)((const GAS float*)P.in[i] + zoff))
        int G = gridDim.x, wg = blockIdx.x; asm volatile("" : "+s"(G), "+s"(wg));
        const int lane = tid & 63, wave = __builtin_amdgcn_readfirstlane(tid >> 6);
        const int gw = wg * 8 + wave, NGW = G * 8;
        const int gt = wg * 512 + tid, NGT = G * 512;
        bf16_t* XB = (bf16_t*)(ws + WS_XB);
        const int l = ph / NPH_LAYER, k = ph % NPH_LAYER;
        const float* xres = (l == 0) ? INP(0) : outp;
#ifdef ONLY
        if (k != ONLY) continue;
#endif
#ifdef SKIPK
        if (k == SKIPK) continue;
#endif
#ifdef SKIPK2
        if (k == SKIPK2) continue;
#endif
        {
#ifdef PROBE_GEMM
        const bool gdry = dflag != 0;
#else
        const bool gdry = false;
#endif
#ifdef PROBE_EW
        const bool edry = dflag != 0;
#else
        const bool edry = false;
#endif
        if (dflag && !(gdry && (k == 1 || k == 4 || k == 5 || k == 6 || k == 8 || k == 9)) && !(edry && (k == 0 || k == 2 || k == 4 || k == 7 || k == 10))) continue;
        switch (k) {
        case 0: {
            LAS float* scr = (LAS float*)(lds + wave * 16384);
            const int I0 = 16 * 264, I1 = 8 * 32, I2 = 8 * 32, I3 = 4 * 32, I4 = 16 * 32, I5 = 16 * 176, I6 = 44 * 32;
            const int NIT = I0 + I1 + I2 + I3 + I4 + I5 + I6;
            for (int it = gw; it < NIT; it += NGW) {
                int r = it;
                if (r < I0) { transpose_item(INP(1) + (size_t)l * DM * INC, DM, INC, (bf16_t*)(ws + W_IN), scr, r, lane); continue; } r -= I0;
                if (r < I1) { transpose_item(INP(3) + (size_t)l * 512 * DM, 512, DM, (bf16_t*)(ws + W_MOBA), scr, r, lane); continue; } r -= I1;
                if (r < I2) { transpose_item(INP(5) + (size_t)l * 512 * DM, 512, DM, (bf16_t*)(ws + W_CONV), scr, r, lane); continue; } r -= I2;
                if (r < I3) { transpose_item(INP(4) + (size_t)l * 256 * DM, 256, DM, (bf16_t*)(ws + W_DIL), scr, r, lane); continue; } r -= I3;
                if (r < I4) { transpose_item(INP(6) + (size_t)l * DM * DM, DM, DM, (bf16_t*)(ws + W_MIX), scr, r, lane); continue; } r -= I4;
                if (r < I5) { transpose_item<true>(INP(9) + (size_t)l * DM * DFF2, DM, DFF2, (bf16_t*)(ws + W_UP), scr, r, lane); continue; } r -= I5;
                transpose_item(INP(12) + (size_t)l * DFF * DM, DFF, DM, (bf16_t*)(ws + W_DOWN), scr, r, lane);
            }
            if (l == 0) {
                const float* x = INP(0);
                for (int it = gt; it < M_TOK * DM / 8; it += NGT) {
                    const f32x4 a = *(const f32x4*)(x + (size_t)it * 8), c = *(const f32x4*)(x + (size_t)it * 8 + 4);
                    u32x4 o; o.x = cvtpk(a[0], a[1]); o.y = cvtpk(a[2], a[3]); o.z = cvtpk(c[0], c[1]); o.w = cvtpk(c[2], c[3]);
                    *(u32x4*)(XB + (size_t)it * 8) = o;
                }
            }
        } break;
        case 1: {
            pg8::SchedIN S{G, wg, (const char*)XB, (const char*)(ws + W_IN), ws};
            pg8::EpiBf16<0> E{gdry};
            pg8::gemm_phase(lds, tid, DM, 2048u, S, E);
        } break;
        case 2: {
            {
                LAS float* red = (LAS float*)lds;
                const bf16_t* KA = (const bf16_t*)(ws + B_KA);
                for (int it = wg; it < 256; it += G) {
                    const int b = it >> 7, j = (it >> 2) & 31, cgp = it & 3;
                    const int col = cgp * 128 + (tid & 127), rp = tid >> 7;
                    const bf16_t* src = KA + (size_t)(b * SEQ + j * 256 + rp * 64) * 512 + col;
                    float s = 0.f;
                    for (int rr = 0; rr < 64; ++rr) s += __uint_as_float((unsigned)src[(size_t)rr * 512] << 16);
                    __syncthreads();
                    red[tid] = s;
                    __syncthreads();
                    if (tid < 128) {
                        const float tot = (red[tid] + red[tid + 128]) + (red[tid + 256] + red[tid + 384]);
                        const int hh = col >> 6, d = col & 63;
                        ((float*)(ws + WS_KMEAN))[(size_t)((b * 8 + hh) * 32 + j) * 64 + d] = tot * (1.0f / 256.0f);
                    }
                }
            }
            {
                bf16_t* BC = (bf16_t*)(ws + B_BC); const bf16_t* CCp = (const bf16_t*)(ws + B_CC); const bf16_t* HHp = (const bf16_t*)(ws + B_HH);
                const float* wsc = INP(2) + (size_t)l * 3 * 512;
                for (int it = gt; it < M_TOK * 64; it += NGT) {
                    const int row = it >> 6, c8 = (it & 63) * 8, tpos = row & (SEQ - 1);
                    float accv[8];
#pragma unroll
                    for (int e = 0; e < 8; ++e) accv[e] = 0.f;
#pragma unroll
                    for (int j = 0; j < 3; ++j) {
                        if (tpos >= j) {
                            const u32x4 cv = *(const u32x4*)(CCp + (size_t)(row - j) * 512 + c8), hv = *(const u32x4*)(HHp + (size_t)(row - j) * 512 + c8);
                            const f32x4 w0 = *(const f32x4*)(wsc + j * 512 + c8), w1 = *(const f32x4*)(wsc + j * 512 + c8 + 4);
                            accv[0] += w0[0] * bflo(cv.x) * bflo(hv.x); accv[1] += w0[1] * bfhi(cv.x) * bfhi(hv.x);
                            accv[2] += w0[2] * bflo(cv.y) * bflo(hv.y); accv[3] += w0[3] * bfhi(cv.y) * bfhi(hv.y);
                            accv[4] += w1[0] * bflo(cv.z) * bflo(hv.z); accv[5] += w1[1] * bfhi(cv.z) * bfhi(hv.z);
                            accv[6] += w1[2] * bflo(cv.w) * bflo(hv.w); accv[7] += w1[3] * bfhi(cv.w) * bfhi(hv.w);
                        }
                    }
                    const u32x4 bv = *(const u32x4*)(BC + (size_t)row * 512 + c8);
                    u32x4 o;
                    o.x = cvtpk(bflo(bv.x) * accv[0], bfhi(bv.x) * accv[1]); o.y = cvtpk(bflo(bv.y) * accv[2], bfhi(bv.y) * accv[3]);
                    o.z = cvtpk(bflo(bv.z) * accv[4], bfhi(bv.z) * accv[5]); o.w = cvtpk(bflo(bv.w) * accv[6], bfhi(bv.w) * accv[7]);
                    if (!edry || accv[0] == 1.2345e33f) *(u32x4*)(BC + (size_t)row * 512 + c8) = o;
                }
            }
        } break;
        case 3: {
            const int vcu = (G % 8 == 0) ? (wg % 8) * (G / 8) + wg / 8 : wg;
            for (int uidx = vcu; uidx < 256; uidx += G) {
                const int bh = uidx >> 4, s = uidx & 15;
                moba_unit(ws, lds, MISC, bh >> 3, bh & 7, s, wave, lane, tid);
                moba_unit(ws, lds, MISC, bh >> 3, bh & 7, 31 - s, wave, lane, tid);
            }
            { const int per = (6144 + NGW - 1) / NGW, t0 = (vcu * 8 + wave) * per;
              for (int t = t0; t < t0 + per && t < 6144; ++t) dil_tile(ws, t, lane); }
        } break;
        case 4: {
            if (!(dflag && !edry)) {
                const bf16_t* QD = (const bf16_t*)(ws + B_QD); const float* LSE = (const float*)(ws + WS_LSE); bf16_t* YD = (bf16_t*)(ws + B_YD);
                for (int it = gt; it < M_TOK * 32; it += NGT) {
                    const int row = it >> 5, hh = (it >> 3) & 3, d8 = (it & 7) * 8;
                    const float l0 = LSE[(size_t)row * 12 + hh], l1 = LSE[(size_t)row * 12 + 4 + hh], l2 = LSE[(size_t)row * 12 + 8 + hh];
                    const float mx = fmaxf(l0, fmaxf(l1, l2));
                    float e0 = __expf(l0 - mx), e1 = __expf(l1 - mx), e2 = __expf(l2 - mx);
                    const float inv = 1.0f / (e0 + e1 + e2); e0 *= inv; e1 *= inv; e2 *= inv;
                    const u32x4 a = *(const u32x4*)(QD + (size_t)row * 768 + hh * 64 + d8), bq = *(const u32x4*)(QD + (size_t)row * 768 + 256 + hh * 64 + d8),
                                c = *(const u32x4*)(QD + (size_t)row * 768 + 512 + hh * 64 + d8);
                    u32x4 o;
                    o.x = cvtpk(e0 * bflo(a.x) + e1 * bflo(bq.x) + e2 * bflo(c.x), e0 * bfhi(a.x) + e1 * bfhi(bq.x) + e2 * bfhi(c.x));
                    o.y = cvtpk(e0 * bflo(a.y) + e1 * bflo(bq.y) + e2 * bflo(c.y), e0 * bfhi(a.y) + e1 * bfhi(bq.y) + e2 * bfhi(c.y));
                    o.z = cvtpk(e0 * bflo(a.z) + e1 * bflo(bq.z) + e2 * bflo(c.z), e0 * bfhi(a.z) + e1 * bfhi(bq.z) + e2 * bfhi(c.z));
                    o.w = cvtpk(e0 * bflo(a.w) + e1 * bflo(bq.w) + e2 * bflo(c.w), e0 * bfhi(a.w) + e1 * bfhi(bq.w) + e2 * bfhi(c.w));
                    *(u32x4*)(YD + (size_t)row * 256 + hh * 64 + d8) = o;
                }
            }
            pg8::SchedSimple S{64, 12, G, wg, (const char*)XB, (size_t)256 * 2048, (const char*)(ws + W_IN) + (size_t)5376 * 2048, (size_t)256 * 2048, 2048u, (bf16_t*)(ws + B_G), 3072};
            pg8::EpiBf16<1> E{gdry};
            if (!(dflag && !gdry)) pg8::gemm_phase(lds, tid, DM, 2048u, S, E);
        } break;
        case 5: {
            bf16_t* MG = XB;
            { pg8::SchedSimple S{64, 4, G, wg, (const char*)(ws + B_QA), (size_t)256 * 1024, (const char*)(ws + W_MOBA), (size_t)256 * 1024, 1024u, MG, 1024};
              pg8::EpiMerge<true> E{(const bf16_t*)(ws + B_G), MG, 0, gdry}; pg8::gemm_phase(lds, tid, 512, 1024u, S, E); }
            { pg8::SchedSimple S{64, 4, G, wg, (const char*)(ws + B_BC), (size_t)256 * 1024, (const char*)(ws + W_CONV), (size_t)256 * 1024, 1024u, MG, 1024};
              pg8::EpiMerge<false> E{(const bf16_t*)(ws + B_G), MG, 1, gdry}; pg8::gemm_phase(lds, tid, 512, 1024u, S, E); }
            { pg8::SchedSimple S{64, 4, G, wg, (const char*)(ws + B_YD), (size_t)256 * 512, (const char*)(ws + W_DIL), (size_t)256 * 512, 512u, MG, 1024};
              pg8::EpiMerge<false> E{(const bf16_t*)(ws + B_G), MG, 2, gdry}; pg8::gemm_phase(lds, tid, 256, 512u, S, E); }
        } break;
        case 6: {
            pg8::SchedSimple S{64, 4, G, wg, (const char*)XB, (size_t)256 * 2048, (const char*)(ws + W_MIX), (size_t)256 * 2048, 2048u, nullptr, 0};
            pg8::EpiRes E{xres, outp, gdry};
            pg8::gemm_phase(lds, tid, DM, 2048u, S, E);
        } break;
        case 7: case 10: {
            const float* gam = INP(k == 7 ? 7 : 13) + (size_t)l * DM; const float* bet = INP(k == 7 ? 8 : 14) + (size_t)l * DM;
            for (int m = gw; m < M_TOK; m += NGW) {
                f32x4* xr = (f32x4*)(outp + (size_t)m * DM) + lane;
                f32x4 v[4]; float s = 0.f;
#pragma unroll
                for (int j = 0; j < 4; ++j) { v[j] = xr[64 * j]; s += (v[j][0] + v[j][1]) + (v[j][2] + v[j][3]); }
                const float mean = wave_sum(s) * (1.f / DM); float s2 = 0.f;
#pragma unroll
                for (int j = 0; j < 4; ++j) { v[j] = v[j] - mean; s2 += (v[j][0] * v[j][0] + v[j][1] * v[j][1]) + (v[j][2] * v[j][2] + v[j][3] * v[j][3]); }
                const float rstd = 1.f / sqrtf(wave_sum(s2) * (1.f / DM) + LN_EPS);
                u32x2* o8 = (u32x2*)(XB + (size_t)m * DM) + lane;
#pragma unroll
                for (int j = 0; j < 4; ++j) {
                    const f32x4 gg = *((const f32x4*)gam + lane + 64 * j), bb = *((const f32x4*)bet + lane + 64 * j);
                    const f32x4 y = v[j] * rstd * gg + bb;
                    if (!edry || y[0] == 1.2345e33f) { xr[64 * j] = y;
                    u32x2 o; o.x = cvtpk(y[0], y[1]); o.y = cvtpk(y[2], y[3]); o8[64 * j] = o; }
                }
            }
        } break;
        case 8: {
            pg8::SchedFfn S{G, wg, (const char*)XB, (const char*)(ws + W_UP)};
            pg8::EpiFfn E{INP(10) + (size_t)l * 3 * DFF2, INP(11) + (size_t)l * DFF2, (bf16_t*)(ws + B_H), (LAS float*)(lds + 131072 + 1024), gdry};
            pg8::gemm_phase(lds, tid, DM, 2048u, S, E);
        } break;
        case 9: {
            pg8::SchedSimple S{64, 4, G, wg, (const char*)(ws + B_H), (size_t)256 * DFF * 2, (const char*)(ws + W_DOWN), (size_t)256 * DFF * 2, (unsigned)(DFF * 2), nullptr, 0};
            pg8::EpiRes E{outp, outp, gdry};
            pg8::gemm_phase(lds, tid, DFF, (unsigned)(DFF * 2), S, E);
        } break;
        default: break;
        }
        }
        if (ph + 1 < P.ph_hi) {
            if (ph == P.ph_lo) grid.sync();
            else xcd_barrier(xbar);
#ifdef PROBE_SYNC
            for (int rep = 0; rep < PROBE_SYNC; ++rep) xcd_barrier(xbar);
#endif
        }
    }
}

constexpr int LDS_BYTES = 131072 + 1024 + 8192;

extern "C" void kernel_launch(void* const* d_in, const int* in_sizes, int n_in, void* d_out, int out_size, void* d_ws, size_t ws_size, hipStream_t stream) {
    static int grid = 0;
    if (grid == 0) {
        if (n_in != 15 || out_size != M_TOK * DM || ws_size < WS_NEED) { fprintf(stderr, "kernel_launch: unexpected shapes (n_in %d out %d ws %zu need %zu)\n", n_in, out_size, ws_size, (size_t)WS_NEED); grid = -1; return; }
        int dev = 0, cus = 0, per_cu = 0;
        hipGetDevice(&dev);
        hipDeviceGetAttribute(&cus, hipDeviceAttributeMultiprocessorCount, dev);
        hipFuncSetAttribute((const void*)mega_fwd, hipFuncAttributeMaxDynamicSharedMemorySize, LDS_BYTES);
        hipOccupancyMaxActiveBlocksPerMultiprocessor(&per_cu, (const void*)mega_fwd, 512, LDS_BYTES);
        if (per_cu < 1) { fprintf(stderr, "kernel_launch: occupancy query says %d blocks/CU\n", per_cu); per_cu = 1; }
        grid = cus;
        (void)hipGetLastError();
    }
    if (grid < 0) return;
    if (hipMemsetAsync(d_ws, 0, 16384, stream) != hipSuccess) { fprintf(stderr, "kernel_launch: memset failed\n"); return; }
    Params p{};
    for (int i = 0; i < 15; ++i) p.in[i] = (const float*)d_in[i];
    p.out = (float*)d_out; p.ws = (unsigned char*)d_ws;
#ifndef MK_SPLIT
    p.ph_lo = 0; p.ph_hi = NPH;
    void* args[] = {&p};
    hipError_t e = hipLaunchCooperativeKernel((const void*)mega_fwd, dim3(grid), dim3(512), args, LDS_BYTES, stream);
    if (e != hipSuccess) fprintf(stderr, "cooperative launch failed: %s (grid %d)\n", hipGetErrorString(e), grid);
#else
    for (int ph = 0; ph < NPH; ++ph) {
        p.ph_lo = ph; p.ph_hi = ph + 1;
        void* args[] = {&p};
        hipError_t e = hipLaunchCooperativeKernel((const void*)mega_fwd, dim3(grid), dim3(512), args, LDS_BYTES, stream);
        if (e != hipSuccess) { fprintf(stderr, "launch %d failed: %s\n", ph, hipGetErrorString(e)); break; }
    }
#endif
}
```
